# Optimizing an MI355X kernel written in HIP

```python
import jax, jax.numpy as jnp
from jax import lax
import numpy as np

D_MODEL = 1024
BATCH = 16
SEQ = 2048
DEPTH = 2

A_GROUPS = 8
A_GROUP_DIM = D_MODEL // 16
A_DIM = A_GROUPS * A_GROUP_DIM
B_GROUPS = 8
B_GROUP_DIM = D_MODEL // 16
B_DIM = B_GROUPS * B_GROUP_DIM
MIX_DIM = A_DIM + B_DIM
IN_EVEN = 2 * A_DIM + 3 * B_DIM
A_CONV_WIDTH = 31
B_CONV_WIDTH = 3
CHUNK = 128
C_GROUPS = 8
C_GROUP_DIM = D_MODEL // 8
C_DIM = C_GROUPS * C_GROUP_DIM
D_FF = 4 * D_MODEL
N_EVEN = (DEPTH + 1) // 2
N_ODD = DEPTH // 2
RMS_EPS = 1e-6
LN_EPS = 1e-5

kernel_name = "hybrid_conformer_shortconv_gmlp_trunk"


def rms_norm(x, g):
    xf = x.astype(jnp.float32)
    y = xf * lax.rsqrt(jnp.mean(xf * xf, axis=-1, keepdims=True) + RMS_EPS)
    return (y * g.astype(jnp.float32)).astype(x.dtype)


def layer_norm(x, g, b):
    xf = x.astype(jnp.float32)
    mu = jnp.mean(xf, axis=-1, keepdims=True)
    xc = xf - mu
    var = jnp.mean(xc * xc, axis=-1, keepdims=True)
    y = xc * lax.rsqrt(var + LN_EPS) * g.astype(jnp.float32) + b.astype(jnp.float32)
    return y.astype(x.dtype)


def causal_depthwise_conv(x, w):
    k = w.shape[0]
    return lax.conv_general_dilated(
        x, w[:, None, :].astype(x.dtype), window_strides=(1,), padding=[(k - 1, 0)],
        dimension_numbers=("NWC", "WIO", "NWC"), feature_group_count=x.shape[-1])


def conv_mixers(h, w_in, conv_a_w, conv_a_b, ln_a_g, ln_a_b, conv_b_w, w_out):
    z = h @ w_in
    a_val, a_gate, b_gate, c_gate, b_val = jnp.split(
        z, [A_DIM, 2 * A_DIM, 2 * A_DIM + B_DIM, 2 * A_DIM + 2 * B_DIM], axis=-1)
    a = a_val * jax.nn.sigmoid(a_gate)
    a = causal_depthwise_conv(a, conv_a_w) + conv_a_b
    a = jax.nn.silu(layer_norm(a, ln_a_g, ln_a_b))
    bo = b_gate * causal_depthwise_conv(c_gate * b_val, conv_b_w)
    return jnp.concatenate([a, bo], axis=-1) @ w_out


def chunked_spatial_gating(h, w_in, b_in, ln_v_g, ln_v_b, w_s, b_s, w_out):
    z = jax.nn.gelu(h @ w_in + b_in, approximate=False)
    u, v = jnp.split(z, 2, axis=-1)
    v = layer_norm(v, ln_v_g, ln_v_b)
    bsz, s, _ = v.shape
    vc = v.reshape(bsz, s // CHUNK, CHUNK, C_GROUPS, C_GROUP_DIM)
    mask = jnp.tril(jnp.ones((CHUNK, CHUNK), dtype=bool))
    ws = jnp.where(mask[None], w_s, 0.0).astype(v.dtype)
    sv = jnp.einsum("gts,bnsgc->bntgc", ws, vc) + b_s.T[None, None, :, :, None].astype(v.dtype)
    y = u * sv.reshape(bsz, s, C_DIM)
    return y @ w_out


def squared_relu_mlp(h, w1, w2):
    a = jax.nn.relu(h @ w1)
    return (a * a) @ w2


def setup_inputs(seed: int = 0) -> dict:
    key = jax.random.key(seed)
    ks = iter(jax.random.split(key, 32))

    def nrm(shape, scale):
        return jax.random.normal(next(ks), shape, jnp.float32) * scale

    def gain(shape):
        return 1.0 + nrm(shape, 0.02)

    d = D_MODEL
    return {
        "x": nrm((BATCH, SEQ, d), 1.0),
        "ev_norm_g": gain((N_EVEN, d)),
        "ev_w_in": nrm((N_EVEN, d, IN_EVEN), d ** -0.5),
        "ev_conv_a_w": nrm((N_EVEN, A_CONV_WIDTH, A_DIM), A_CONV_WIDTH ** -0.5),
        "ev_conv_a_b": nrm((N_EVEN, A_DIM), 0.02),
        "ev_ln_a_g": gain((N_EVEN, A_DIM)),
        "ev_ln_a_b": nrm((N_EVEN, A_DIM), 0.02),
        "ev_conv_b_w": nrm((N_EVEN, B_CONV_WIDTH, B_DIM), B_CONV_WIDTH ** -0.5),
        "ev_w_out": nrm((N_EVEN, MIX_DIM, d), MIX_DIM ** -0.5),
        "od_norm_g": gain((N_ODD, d)),
        "od_w_in": nrm((N_ODD, d, 2 * C_DIM), d ** -0.5),
        "od_b_in": nrm((N_ODD, 2 * C_DIM), 0.02),
        "od_ln_v_g": gain((N_ODD, C_DIM)),
        "od_ln_v_b": nrm((N_ODD, C_DIM), 0.02),
        "od_w_s": nrm((N_ODD, C_GROUPS, CHUNK, CHUNK), CHUNK ** -0.5),
        "od_b_s": gain((N_ODD, C_GROUPS, CHUNK)),
        "od_w_out": nrm((N_ODD, C_DIM, d), C_DIM ** -0.5),
        "mlp_norm_g": gain((DEPTH, d)),
        "mlp_w1": nrm((DEPTH, d, D_FF), d ** -0.5),
        "mlp_w2": nrm((DEPTH, D_FF, d), D_FF ** -0.5),
        "final_norm_g": gain((d,)),
    }


def reference(x, ev_norm_g, ev_w_in, ev_conv_a_w, ev_conv_a_b, ev_ln_a_g, ev_ln_a_b,
              ev_conv_b_w, ev_w_out, od_norm_g, od_w_in, od_b_in, od_ln_v_g, od_ln_v_b,
              od_w_s, od_b_s, od_w_out, mlp_norm_g, mlp_w1, mlp_w2, final_norm_g):
    h = x
    for i in range(DEPTH):
        j = i // 2
        if i % 2 == 0:
            h = h + conv_mixers(rms_norm(h, ev_norm_g[j]), ev_w_in[j], ev_conv_a_w[j],
                                ev_conv_a_b[j], ev_ln_a_g[j], ev_ln_a_b[j],
                                ev_conv_b_w[j], ev_w_out[j])
        else:
            h = h + chunked_spatial_gating(rms_norm(h, od_norm_g[j]), od_w_in[j], od_b_in[j],
                                           od_ln_v_g[j], od_ln_v_b[j], od_w_s[j],
                                           od_b_s[j], od_w_out[j])
        h = h + squared_relu_mlp(rms_norm(h, mlp_norm_g[i]), mlp_w1[i], mlp_w2[i])
    return rms_norm(h, final_norm_g)
```

```cpp
#include <hip/hip_runtime.h>
#include <hip/hip_cooperative_groups.h>
#include <cstdio>
#include <utility>
namespace cg = cooperative_groups;

#define LAS __attribute__((address_space(3)))
typedef unsigned short bf16_t;
typedef short bf16x8 __attribute__((ext_vector_type(8)));
typedef short s16x4 __attribute__((ext_vector_type(4)));
typedef float f32x4 __attribute__((ext_vector_type(4)));
typedef float f32x2 __attribute__((ext_vector_type(2)));
typedef unsigned u32x4 __attribute__((ext_vector_type(4)));
typedef unsigned u32x2 __attribute__((ext_vector_type(2)));

constexpr int D = 1024, SEQ = 2048, M = 16 * 2048, FF = 4096, NIN0 = 2560, NG1 = 1536, NIN1 = 2048;
constexpr float RMS_EPS = 1e-6f, LN_EPS = 1e-5f;
constexpr size_t MiB = 1u << 20;
constexpr size_t WS_WIN0 = 0, WS_WOUT0 = 5 * MiB, WS_W1_0 = 7 * MiB, WS_W2_0 = 15 * MiB, WS_WIN1 = 23 * MiB, WS_WOUT1 = 27 * MiB, WS_W1_1 = 29 * MiB, WS_W2_1 = 37 * MiB, WS_WSB = 45 * MiB;
constexpr size_t WS_SS = 46 * MiB  , WS_VST = 56 * MiB  , WS_XB = 64 * MiB  ;
constexpr size_t WS_R = 128 * MiB  , WS_HID = WS_R, WS_END = 384 * MiB, WS_BAR = 62 * MiB;

__device__ __forceinline__ unsigned cvt_pk_bf16(float lo, float hi) { unsigned r; asm volatile("v_cvt_pk_bf16_f32 %0, %1, %2" : "=v"(r) : "v"(lo), "v"(hi)); return r; }
__device__ __forceinline__ float bf_lo(unsigned v) { return __builtin_bit_cast(float, v << 16); }
__device__ __forceinline__ float bf_hi(unsigned v) { return __builtin_bit_cast(float, v & 0xffff0000u); }
__device__ __forceinline__ float relu1(float x) { float r; asm("v_max_f32_e32 %0, 0, %1" : "=v"(r) : "v"(x)); return r; }
__device__ __forceinline__ float fast_sigmoid(float x) { return __builtin_amdgcn_rcpf(1.0f + __builtin_amdgcn_exp2f(x * -1.44269504089f)); }

namespace pg8 {
constexpr int BM = 256, BK = 64, HALF = 128, HTB = HALF * BK * 2, STAGE_BYTES = 8 * HTB, NXCD = 8, WGM = 8;
__host__ __device__ __forceinline__ int lds_byte(int r, int c) { const int st = (r >> 4) * 2 + (c >> 5), rr = r & 15, cc = c & 31, ob = rr * 64 + cc * 2; return st * 1024 + (ob ^ (((ob >> 9) & 1) << 5)); }
__host__ __device__ __forceinline__ void stage_rc(int b, int& R, int& C) { const int st = b / 1024, sb = b % 1024, swz = sb ^ (((sb >> 9) & 1) << 5); R = (st >> 1) * 16 + swz / 64; C = (st & 1) * 32 + (swz % 64) / 2; }
__host__ __device__ __forceinline__ int perm32(int rho) { const int n = rho >> 4, i = rho & 15; return 8 * (i >> 2) + 4 * n + (i & 3); }
struct Unit { int pm, pn; };
struct Gemm { const bf16_t* A; const bf16_t* Bt; int M, N, K; };
struct StaticOrder {
    int nM, nN, nwg, G, c, rev;
    __device__ void init(int M_, int N_, int G_, int c_) { nM = M_ / BM; nN = N_ / BM; nwg = nM * nN; G = G_; c = c_; rev = 0; }
    __device__ bool next(int i, Unit& u) const {
        const int nr = nwg / G; const int ii = (rev && nr * G == nwg) ? nr - 1 - i : i; if (ii < 0) return false;
        const long L = (long)ii * G + c; if (L >= nwg) return false;
        int wgid = (int)L; { const int q = nwg / NXCD, r = nwg % NXCD, xcd = wgid % NXCD, off = wgid / NXCD; wgid = (xcd < r ? xcd * (q + 1) : r * (q + 1) + (xcd - r) * q) + off; }
        const int nig = WGM * nN, gid = wgid / nig, fm = gid * WGM, gsz = (nM - fm) < WGM ? (nM - fm) : WGM;
        u.pm = fm + ((wgid % nig) % gsz); u.pn = (wgid % nig) / gsz; return true;
    }
};
__device__ __forceinline__ f32x2 gelu_pk(f32x2 v) {
    const f32x2 av = __builtin_elementwise_abs(v), d = av * 0.2316418882f + 1.0f;
    f32x2 t; t.x = __builtin_amdgcn_rcpf(d.x); t.y = __builtin_amdgcn_rcpf(d.y);
    f32x2 q = t * 0.5307027145f + (-0.7265760135f); q = q * t + 0.7107068705f; q = q * t + (-0.142248368f); q = q * t + 0.127414796f; q = q * t;
    const f32x2 s = (v * v) * (-0.72134752044f);
    f32x2 e; e.x = __builtin_amdgcn_exp2f(s.x); e.y = __builtin_amdgcn_exp2f(s.y);
    const f32x2 m = v * (q * e), r = v - m;
    f32x2 o; o.x = v.x < 0.f ? m.x : r.x; o.y = v.y < 0.f ? m.y : r.y; return o;
}
__device__ __forceinline__ float row_rs(const float* ss, int row) {
    const f32x4* p = (const f32x4*)(ss + (size_t)row * 16); f32x4 a = p[0], b = p[1], c = p[2], d = p[3]; a = (a + b) + (c + d);
    return __builtin_amdgcn_rsqf(((a.x + a.y) + (a.z + a.w)) * (1.0f / 1024.0f) + RMS_EPS);
}

struct EpiInEven {
    static constexpr bool PERM = true, AFTER_DRAIN = false;
    static constexpr bool NEEDS_RS = true;
    bf16_t* G1; const float* ss; const LAS float* rs_tab;
    __device__ __forceinline__ void operator()(const f32x4 (&acc)[2][2][4][2], const Unit& u, int ui, int wr, int wc, int fr, int fq) const {
        const LAS float* rsp = rs_tab + ui * 256 + wr * 64 + fr; float rsv[2][4];
#pragma unroll
        for (int ai = 0; ai < 2; ++ai)
#pragma unroll
            for (int m = 0; m < 4; ++m) rsv[ai][m] = rsp[ai * HALF + m * 16];
        const int row0 = u.pm * BM + wr * 64 + fr;
#pragma unroll
        for (int ai = 0; ai < 2; ++ai)
#pragma unroll
            for (int m = 0; m < 4; ++m) {
                const int row = row0 + ai * HALF + m * 16; const float r = rsv[ai][m];
                bf16_t* rowp = G1 + (size_t)row * NG1 + wc * 32 + 8 * fq;
                if (u.pn < 4) {
                    f32x4 v0 = acc[ai][0][m][0] * r, v1 = acc[ai][0][m][1] * r, g0 = acc[ai][1][m][0] * r, g1 = acc[ai][1][m][1] * r;
#pragma unroll
                    for (int j = 0; j < 4; ++j) { v0[j] *= fast_sigmoid(g0[j]); v1[j] *= fast_sigmoid(g1[j]); }
                    u32x4 w; w.x = cvt_pk_bf16(v0[0], v0[1]); w.y = cvt_pk_bf16(v0[2], v0[3]); w.z = cvt_pk_bf16(v1[0], v1[1]); w.w = cvt_pk_bf16(v1[2], v1[3]);
                    *(u32x4*)(rowp + 128 * u.pn) = w;
                } else if (u.pn < 8) {
                    const float r2 = r * r; f32x4 v0 = acc[ai][0][m][0] * acc[ai][1][m][0] * r2, v1 = acc[ai][0][m][1] * acc[ai][1][m][1] * r2;
                    u32x4 w; w.x = cvt_pk_bf16(v0[0], v0[1]); w.y = cvt_pk_bf16(v0[2], v0[3]); w.z = cvt_pk_bf16(v1[0], v1[1]); w.w = cvt_pk_bf16(v1[2], v1[3]);
                    *(u32x4*)(rowp + 512 + 128 * (u.pn - 4)) = w;
                } else {
#pragma unroll
                    for (int bj = 0; bj < 2; ++bj) { f32x4 v0 = acc[ai][bj][m][0] * r, v1 = acc[ai][bj][m][1] * r;
                        u32x4 w; w.x = cvt_pk_bf16(v0[0], v0[1]); w.y = cvt_pk_bf16(v0[2], v0[3]); w.z = cvt_pk_bf16(v1[0], v1[1]); w.w = cvt_pk_bf16(v1[2], v1[3]);
                        *(u32x4*)(rowp + 1024 + 256 * (u.pn - 8) + 128 * bj) = w; }
                }
            }
    }
};
struct EpiRes {
    static constexpr bool PERM = true, AFTER_DRAIN = false;
    static constexpr bool NEEDS_RS = false;
    const bf16_t* res; bf16_t* XB; float* ssout;
    __device__ __forceinline__ void operator()(const f32x4 (&acc)[2][2][4][2], const Unit& u, int ui, int wr, int wc, int fr, int fq) const {
        const int row0 = u.pm * BM + wr * 64 + fr, col0 = u.pn * BM + wc * 32 + 8 * fq;
        u32x4 rv[2][4][2];
#pragma unroll
        for (int ai = 0; ai < 2; ++ai)
#pragma unroll
            for (int m = 0; m < 4; ++m)
#pragma unroll
                for (int bj = 0; bj < 2; ++bj) rv[ai][m][bj] = *(const u32x4*)(res + (size_t)(row0 + ai * HALF + m * 16) * D + col0 + bj * HALF);
#pragma unroll
        for (int ai = 0; ai < 2; ++ai) {
#pragma unroll
            for (int m = 0; m < 4; ++m) {
                const int row = row0 + ai * HALF + m * 16; const size_t off = (size_t)row * D + col0; float q = 0.f;
#pragma unroll
                for (int bj = 0; bj < 2; ++bj) {
                    const u32x4 r = rv[ai][m][bj];
                    const f32x4 h0 = (f32x4){bf_lo(r.x), bf_hi(r.x), bf_lo(r.y), bf_hi(r.y)} + acc[ai][bj][m][0], h1 = (f32x4){bf_lo(r.z), bf_hi(r.z), bf_lo(r.w), bf_hi(r.w)} + acc[ai][bj][m][1];
                    q += (h0[0] * h0[0] + h0[1] * h0[1]) + (h0[2] * h0[2] + h0[3] * h0[3]) + (h1[0] * h1[0] + h1[1] * h1[1]) + (h1[2] * h1[2] + h1[3] * h1[3]);
                    u32x4 w; w.x = cvt_pk_bf16(h0[0], h0[1]); w.y = cvt_pk_bf16(h0[2], h0[3]); w.z = cvt_pk_bf16(h1[0], h1[1]); w.w = cvt_pk_bf16(h1[2], h1[3]);
                    *(u32x4*)(XB + off + bj * HALF) = w;
                }
                q += __shfl_xor(q, 16); q += __shfl_xor(q, 32);
                if (fq == 0) ssout[(size_t)row * 16 + u.pn * 4 + wc] = q;
            }
            asm volatile("" ::: "memory");
        }
    }
};
struct EpiResFinal {
    static constexpr bool PERM = true, AFTER_DRAIN = false, NEEDS_RS = false;
    const bf16_t* res; float* out; const float* gfin; unsigned* xq; unsigned* cnt; unsigned* tmo; LAS float* sl;
    __device__ __forceinline__ void operator()(f32x4 (&acc)[2][2][4][2], const Unit& u, int ui, int wr, int wc, int fr, int fq) const {
        const int row0 = u.pm * BM + wr * 64 + fr, col0 = u.pn * BM + wc * 32 + 8 * fq, tid = threadIdx.x;
        LAS float* part = sl; LAS float* rsT = sl + 1024;
#pragma unroll
        for (int ai = 0; ai < 2; ++ai) {
            u32x4 rv[4][2];
#pragma unroll
            for (int m = 0; m < 4; ++m)
#pragma unroll
                for (int bj = 0; bj < 2; ++bj) rv[m][bj] = *(const u32x4*)(res + (size_t)(row0 + ai * HALF + m * 16) * D + col0 + bj * HALF);
#pragma unroll
            for (int m = 0; m < 4; ++m) { float q = 0.f;
#pragma unroll
                for (int bj = 0; bj < 2; ++bj) { const u32x4 r = rv[m][bj];
                    const f32x4 h0 = (f32x4){bf_lo(r.x), bf_hi(r.x), bf_lo(r.y), bf_hi(r.y)} + acc[ai][bj][m][0], h1 = (f32x4){bf_lo(r.z), bf_hi(r.z), bf_lo(r.w), bf_hi(r.w)} + acc[ai][bj][m][1];
                    q += (h0[0] * h0[0] + h0[1] * h0[1]) + (h0[2] * h0[2] + h0[3] * h0[3]) + (h1[0] * h1[0] + h1[1] * h1[1]) + (h1[2] * h1[2] + h1[3] * h1[3]);
                    acc[ai][bj][m][0] = h0; acc[ai][bj][m][1] = h1; }
                q += __shfl_xor(q, 16); q += __shfl_xor(q, 32);
                if (fq == 0) part[(ai * HALF + wr * 64 + m * 16 + fr) * 4 + wc] = q; }
        }
        asm volatile("s_waitcnt lgkmcnt(0)" ::: "memory"); __builtin_amdgcn_s_barrier(); asm volatile("" ::: "memory");
        if (tid < 256) { const f32x4 p = *(const LAS f32x4*)(part + tid * 4);
            __hip_atomic_store(xq + (size_t)(u.pm * BM + tid) * 4 + u.pn, __builtin_bit_cast(unsigned, (p.x + p.y) + (p.z + p.w)), __ATOMIC_RELAXED, __HIP_MEMORY_SCOPE_AGENT); }
        asm volatile("s_waitcnt vmcnt(0)" ::: "memory"); __builtin_amdgcn_s_barrier(); asm volatile("" ::: "memory");
        if (tid == 0) { unsigned* c = cnt + 16 * u.pm; __hip_atomic_fetch_add(c, 1u, __ATOMIC_RELAXED, __HIP_MEMORY_SCOPE_AGENT);
            unsigned sp = 0u;
            while (__hip_atomic_load(c, __ATOMIC_RELAXED, __HIP_MEMORY_SCOPE_AGENT) < 4u) { __builtin_amdgcn_s_sleep(1);
                if ((++sp & 255u) == 0u) { if (__hip_atomic_load(tmo, __ATOMIC_RELAXED, __HIP_MEMORY_SCOPE_AGENT)) break; if (sp > (1u << 18)) { atomicAdd(tmo, 1u); break; } } }
            __builtin_amdgcn_fence(__ATOMIC_ACQUIRE, "agent"); asm volatile("s_waitcnt vmcnt(0)" ::: "memory"); }
        __builtin_amdgcn_s_barrier(); asm volatile("" ::: "memory");
        if (tid < 256) { const unsigned* p = xq + (size_t)(u.pm * BM + tid) * 4; float sm = 0.f;
#pragma unroll
            for (int t = 0; t < 4; ++t) sm += __builtin_bit_cast(float, __hip_atomic_load(p + t, __ATOMIC_RELAXED, __HIP_MEMORY_SCOPE_AGENT));
            rsT[tid] = __builtin_amdgcn_rsqf(sm * (1.0f / 1024.0f) + RMS_EPS); }
        asm volatile("s_waitcnt lgkmcnt(0)" ::: "memory"); __builtin_amdgcn_s_barrier(); asm volatile("" ::: "memory");
        f32x4 gv[2][2];
#pragma unroll
        for (int bj = 0; bj < 2; ++bj)
#pragma unroll
            for (int n = 0; n < 2; ++n) gv[bj][n] = *(const f32x4*)(gfin + col0 + bj * HALF + 4 * n);
#pragma unroll
        for (int ai = 0; ai < 2; ++ai)
#pragma unroll
            for (int m = 0; m < 4; ++m) { const int rl = ai * HALF + wr * 64 + m * 16 + fr; const float r = rsT[rl]; float* orow = out + (size_t)(u.pm * BM + rl) * D + col0;
#pragma unroll
                for (int bj = 0; bj < 2; ++bj)
#pragma unroll
                    for (int n = 0; n < 2; ++n) *(f32x4*)(orow + bj * HALF + 4 * n) = acc[ai][bj][m][n] * r * gv[bj][n]; }
    }
};
struct EpiHid {
    static constexpr bool PERM = true, AFTER_DRAIN = false;
    static constexpr bool NEEDS_RS = true;
    bf16_t* O; const float* ss; const LAS float* rs_tab;
    __device__ __forceinline__ void operator()(const f32x4 (&acc)[2][2][4][2], const Unit& u, int ui, int wr, int wc, int fr, int fq) const {
        const LAS float* rsp = rs_tab + ui * 256 + wr * 64 + fr; float rsv[2][4];
#pragma unroll
        for (int ai = 0; ai < 2; ++ai)
#pragma unroll
            for (int m = 0; m < 4; ++m) rsv[ai][m] = rsp[ai * HALF + m * 16];
        const int row0 = u.pm * BM + wr * 64 + fr, col0 = u.pn * BM + wc * 32 + 8 * fq;
#pragma unroll
        for (int ai = 0; ai < 2; ++ai)
#pragma unroll
            for (int m = 0; m < 4; ++m) {
                const int row = row0 + ai * HALF + m * 16; const float r = rsv[ai][m], r2 = r * r;
                bf16_t* rowp = O + (size_t)row * FF + col0;
#pragma unroll
                for (int bj = 0; bj < 2; ++bj) {
                    f32x4 v0, v1;
#pragma unroll
                    for (int j = 0; j < 4; ++j) { v0[j] = relu1(acc[ai][bj][m][0][j]); v1[j] = relu1(acc[ai][bj][m][1][j]); }
                    v0 = v0 * v0 * r2; v1 = v1 * v1 * r2;
                    u32x4 w; w.x = cvt_pk_bf16(v0[0], v0[1]); w.y = cvt_pk_bf16(v0[2], v0[3]); w.z = cvt_pk_bf16(v1[0], v1[1]); w.w = cvt_pk_bf16(v1[2], v1[3]);
                    __builtin_nontemporal_store(w, (u32x4*)(rowp + bj * HALF)); }
            }
    }
};
struct EpiInOdd {
    static constexpr bool PERM = true, AFTER_DRAIN = false;
    static constexpr bool NEEDS_RS = true;
    bf16_t* U; bf16_t* V; const float* ss; const float* bias; f32x2* vst; const LAS float* rs_tab;
    __device__ __forceinline__ void operator()(const f32x4 (&acc)[2][2][4][2], const Unit& u, int ui, int wr, int wc, int fr, int fq) const {
        const LAS float* rsp = rs_tab + ui * 256 + wr * 64 + fr; float rsv[2][4];
#pragma unroll
        for (int ai = 0; ai < 2; ++ai)
#pragma unroll
            for (int m = 0; m < 4; ++m) rsv[ai][m] = rsp[ai * HALF + m * 16];
        const int row0 = u.pm * BM + wr * 64 + fr, colt = wc * 32 + 8 * fq; const bool isv = u.pn >= 4;
        bf16_t* base = isv ? V : U; const int col0 = (isv ? u.pn - 4 : u.pn) * BM + colt;
        f32x4 bv[2][2];
#pragma unroll
        for (int bj = 0; bj < 2; ++bj)
#pragma unroll
            for (int n = 0; n < 2; ++n) bv[bj][n] = *(const f32x4*)(bias + u.pn * BM + colt + bj * HALF + 4 * n);
#pragma unroll
        for (int ai = 0; ai < 2; ++ai)
#pragma unroll
            for (int m = 0; m < 4; ++m) {
                const int row = row0 + ai * HALF + m * 16; const float r = rsv[ai][m]; float s = 0.f, q = 0.f;
                bf16_t* rowp = base + (size_t)row * D + col0;
#pragma unroll
                for (int bj = 0; bj < 2; ++bj) {
                    f32x4 v0 = acc[ai][bj][m][0] * r + bv[bj][0], v1 = acc[ai][bj][m][1] * r + bv[bj][1];
                    f32x2 a = gelu_pk((f32x2){v0[0], v0[1]}), b = gelu_pk((f32x2){v0[2], v0[3]}), c = gelu_pk((f32x2){v1[0], v1[1]}), d = gelu_pk((f32x2){v1[2], v1[3]});
                    s += (a.x + a.y) + (b.x + b.y) + (c.x + c.y) + (d.x + d.y);
                    q += (a.x * a.x + a.y * a.y) + (b.x * b.x + b.y * b.y) + (c.x * c.x + c.y * c.y) + (d.x * d.x + d.y * d.y);
                    u32x4 w; w.x = cvt_pk_bf16(a.x, a.y); w.y = cvt_pk_bf16(b.x, b.y); w.z = cvt_pk_bf16(c.x, c.y); w.w = cvt_pk_bf16(d.x, d.y);
                    *(u32x4*)(rowp + bj * HALF) = w; }
                if (isv) { s += __shfl_xor(s, 16); s += __shfl_xor(s, 32); q += __shfl_xor(q, 16); q += __shfl_xor(q, 32);
                    if (fq == 0) vst[(size_t)row * 16 + (u.pn - 4) * 4 + wc] = (f32x2){s, q}; }
            }
    }
};

template <class Epi, class Sched, bool ALIGN_EPI = false, bool SP2 = false>
__device__ __forceinline__ void gemm_phase(LAS unsigned char* lds, const Gemm g, const Sched& S, const Epi& E) {
    int tid_ = threadIdx.x; asm volatile("" : "+v"(tid_));
    const int tid = tid_, wid = __builtin_amdgcn_readfirstlane(tid >> 6), lane = tid & 63, wr = wid >> 2, wc = wid & 3, fr = lane & 15, fq = lane >> 4;
    const int K = g.K, nt = K / BK;
    unsigned voffA[2], voffB[2];
#pragma unroll
    for (int i = 0; i < 2; ++i) { int R, C; stage_rc(tid * 16 + i * 8192, R, C); const int Rb = Epi::PERM ? ((R & ~31) + perm32(R & 31)) : R;
        voffA[i] = (unsigned)(R * K + C) * 2u; voffB[i] = (unsigned)(Rb * K + C) * 2u; }
    const size_t kstep = (size_t)(BK * 2);
    const size_t hstep = (size_t)HALF * K * 2;
    const size_t tstep = 2 * hstep;
    const unsigned ldsw = (unsigned)wid * 1024u;
    const int aoff = lds_byte(wr * 64 + fr, fq * 8), boff = lds_byte(wc * 32 + fr, fq * 8);
#define PG8_SA(b, h) (((b) * 2 + (h)) * HTB)
#define PG8_SB(b, h) ((4 + (b) * 2 + (h)) * HTB)
#define PG8_STAGE(bufoff, gbase, voff) do { _Pragma("unroll") for (int _i = 0; _i < 2; ++_i) \
        __builtin_amdgcn_global_load_lds((const unsigned*)((const char*)(gbase) + (voff)[_i]), (LAS unsigned*)(lds + (bufoff) + ldsw + _i * 8192), 16, 0, 0); } while (0)
#define PG8_LDA(dst, b, h) do { _Pragma("unroll") for (int m = 0; m < 4; ++m) _Pragma("unroll") for (int k = 0; k < 2; ++k) dst[m][k] = *(const LAS bf16x8*)(lds + PG8_SA(b, h) + aoff + m * 2048 + k * 1024); } while (0)
#define PG8_LDB(dst, b, h) do { _Pragma("unroll") for (int n = 0; n < 2; ++n) _Pragma("unroll") for (int k = 0; k < 2; ++k) dst[n][k] = *(const LAS bf16x8*)(lds + PG8_SB(b, h) + boff + n * 2048 + k * 1024); } while (0)
#define PG8_MMA(ai, bj, At, Bt) do { __builtin_amdgcn_s_setprio(1); _Pragma("unroll") for (int m = 0; m < 4; ++m) _Pragma("unroll") for (int n = 0; n < 2; ++n) _Pragma("unroll") for (int k = 0; k < 2; ++k) \
        acc[ai][bj][m][n] = __builtin_amdgcn_mfma_f32_16x16x32_bf16(Bt[n][k], At[m][k], acc[ai][bj][m][n], 0, 0, 0); __builtin_amdgcn_s_setprio(0); } while (0)
#define PG8_WAIT_V(n) asm volatile("s_waitcnt vmcnt(" #n ")" ::: "memory")
#define PG8_WAIT_L(n) asm volatile("s_waitcnt lgkmcnt(" #n ")" ::: "memory")
#define PG8_BAR __builtin_amdgcn_s_barrier()
#define PG8_SCHED __builtin_amdgcn_sched_barrier(0)
    Unit cur, nxt; int ui = 0;
    if (!S.next(0, cur)) return;
    f32x4 acc[2][2][4][2];
#pragma unroll
    for (int a = 0; a < 2; ++a)
#pragma unroll
        for (int b = 0; b < 2; ++b)
#pragma unroll
            for (int m = 0; m < 4; ++m)
#pragma unroll
                for (int n = 0; n < 2; ++n) acc[a][b][m][n] = (f32x4){0.f, 0.f, 0.f, 0.f};
    bf16x8 At[4][2], B0[2][2], B1[2][2];
    const char* cA = (const char*)g.A + (size_t)cur.pm * tstep; const char* cB = (const char*)g.Bt + (size_t)cur.pn * tstep;
    if constexpr (SP2) {
        PG8_STAGE(PG8_SB(0, 0), cB, voffB); PG8_STAGE(PG8_SB(0, 1), cB + hstep, voffB); PG8_STAGE(PG8_SA(0, 0), cA, voffA); PG8_STAGE(PG8_SA(0, 1), cA + hstep, voffA);
        if constexpr (Epi::NEEDS_RS) {
            LAS float* tab = (LAS float*)(lds + STAGE_BYTES + 256); Unit pu;
            for (int i = tid >> 8; S.next(i, pu); i += 2) tab[i * 256 + (tid & 255)] = row_rs(E.ss, pu.pm * BM + (tid & 255));
            PG8_WAIT_L(0);
        }
        if (wr == 1) PG8_BAR;
        PG8_WAIT_V(2); PG8_BAR;
        PG8_STAGE(PG8_SB(1, 0), cB + kstep, voffB); PG8_STAGE(PG8_SA(1, 0), cA + kstep, voffA); PG8_STAGE(PG8_SB(1, 1), cB + hstep + kstep, voffB);
        PG8_WAIT_V(6); PG8_BAR;
    } else {
        PG8_STAGE(PG8_SB(0, 0), cB, voffB); PG8_STAGE(PG8_SA(0, 0), cA, voffA); PG8_STAGE(PG8_SB(0, 1), cB + hstep, voffB); PG8_STAGE(PG8_SA(0, 1), cA + hstep, voffA);
        if (wr == 1) PG8_BAR;
        PG8_WAIT_V(4); PG8_BAR;
        PG8_STAGE(PG8_SB(1, 0), cB + kstep, voffB); PG8_STAGE(PG8_SA(1, 0), cA + kstep, voffA); PG8_STAGE(PG8_SB(1, 1), cB + hstep + kstep, voffB);
        PG8_WAIT_V(6); PG8_BAR;
    }
    for (;;) {
        const bool has_next = S.next(ui + 1, nxt);
        const char* nA = has_next ? (const char*)g.A + (size_t)nxt.pm * tstep : cA; const char* nB = has_next ? (const char*)g.Bt + (size_t)nxt.pn * tstep : cB;
        for (int t = 0; t < nt; t += 2) {
            const bool last = (t == nt - 2);
            const char* a1 = cA + (size_t)(t + 1) * kstep;
            const char* a2 = last ? nA : cA + (size_t)(t + 2) * kstep; const char* b2 = last ? nB : cB + (size_t)(t + 2) * kstep;
            const char* a3 = a2 + kstep; const char* b3 = b2 + kstep;
            if constexpr (SP2) {
            PG8_LDB(B0, 0, 0); PG8_LDB(B1, 0, 1); PG8_SCHED; PG8_LDA(At, 0, 0); PG8_STAGE(PG8_SA(1, 1), a1 + hstep, voffA);
            PG8_WAIT_V(8); PG8_WAIT_L(0); PG8_BAR; PG8_MMA(0, 0, At, B0); PG8_MMA(0, 1, At, B1); PG8_BAR; PG8_SCHED;
            PG8_LDA(At, 0, 1); PG8_STAGE(PG8_SB(0, 0), b2, voffB); PG8_STAGE(PG8_SB(0, 1), b2 + hstep, voffB); PG8_STAGE(PG8_SA(0, 0), a2, voffA);
            PG8_WAIT_V(8); PG8_WAIT_L(0); PG8_BAR; PG8_MMA(1, 0, At, B0); PG8_MMA(1, 1, At, B1); PG8_BAR; PG8_SCHED;
            PG8_LDB(B0, 1, 0); PG8_LDB(B1, 1, 1); PG8_SCHED; PG8_LDA(At, 1, 0); PG8_STAGE(PG8_SA(0, 1), a2 + hstep, voffA);
            PG8_WAIT_V(8); PG8_WAIT_L(0); PG8_BAR; PG8_MMA(0, 0, At, B0); PG8_MMA(0, 1, At, B1); PG8_BAR; PG8_SCHED;
            PG8_LDA(At, 1, 1); PG8_STAGE(PG8_SB(1, 0), b3, voffB); PG8_STAGE(PG8_SB(1, 1), b3 + hstep, voffB); PG8_STAGE(PG8_SA(1, 0), a3, voffA);
            PG8_WAIT_V(8); PG8_WAIT_L(0); PG8_BAR; PG8_MMA(1, 0, At, B0); PG8_MMA(1, 1, At, B1); PG8_BAR; PG8_SCHED;
            } else {
            PG8_LDB(B0, 0, 0); PG8_SCHED; PG8_LDA(At, 0, 0); PG8_STAGE(PG8_SA(1, 1), a1 + hstep, voffA);
            PG8_WAIT_L(8); PG8_BAR; PG8_WAIT_L(0); PG8_MMA(0, 0, At, B0); PG8_BAR; PG8_SCHED;
            PG8_LDB(B1, 0, 1); PG8_STAGE(PG8_SB(0, 0), b2, voffB);
            PG8_BAR; PG8_WAIT_L(0); PG8_MMA(0, 1, At, B1); PG8_BAR;
            PG8_LDA(At, 0, 1); PG8_STAGE(PG8_SA(0, 0), a2, voffA);
            PG8_BAR; PG8_WAIT_L(0); PG8_MMA(1, 0, At, B0); PG8_BAR; PG8_SCHED;
            PG8_STAGE(PG8_SB(0, 1), b2 + hstep, voffB);
            PG8_WAIT_V(6); PG8_BAR; PG8_MMA(1, 1, At, B1); PG8_BAR;
            PG8_LDB(B0, 1, 0); PG8_SCHED; PG8_LDA(At, 1, 0); PG8_STAGE(PG8_SA(0, 1), a2 + hstep, voffA);
            PG8_WAIT_L(8); PG8_BAR; PG8_WAIT_L(0); PG8_MMA(0, 0, At, B0); PG8_BAR; PG8_SCHED;
            PG8_LDB(B1, 1, 1); PG8_STAGE(PG8_SB(1, 0), b3, voffB);
            PG8_BAR; PG8_WAIT_L(0); PG8_MMA(0, 1, At, B1); PG8_BAR;
            PG8_LDA(At, 1, 1); PG8_STAGE(PG8_SA(1, 0), a3, voffA);
            PG8_BAR; PG8_WAIT_L(0); PG8_MMA(1, 0, At, B0); PG8_BAR; PG8_SCHED;
            PG8_STAGE(PG8_SB(1, 1), b3 + hstep, voffB);
            PG8_WAIT_V(6); PG8_BAR; PG8_MMA(1, 1, At, B1); PG8_BAR;
            }
        }
        if constexpr (ALIGN_EPI) { if (wr == 0) PG8_BAR; }
        E(acc, cur, ui, wr, wc, fr, fq);
        if (!has_next) break;
#pragma unroll
        for (int a = 0; a < 2; ++a)
#pragma unroll
            for (int b = 0; b < 2; ++b)
#pragma unroll
                for (int m = 0; m < 4; ++m)
#pragma unroll
                    for (int n = 0; n < 2; ++n) acc[a][b][m][n] = (f32x4){0.f, 0.f, 0.f, 0.f};
        cur = nxt; cA = nA; cB = nB; ++ui;
        if constexpr (ALIGN_EPI) { if (wr == 1) PG8_BAR; }
    }
    PG8_WAIT_V(0);
    if constexpr (!ALIGN_EPI) { if (wr == 0) PG8_BAR; }
    PG8_BAR;
#undef PG8_SA
#undef PG8_SB
#undef PG8_STAGE
#undef PG8_LDA
#undef PG8_LDB
#undef PG8_MMA
#undef PG8_WAIT_V
#undef PG8_WAIT_L
#undef PG8_BAR
#undef PG8_SCHED
}
}

constexpr int NWAVES = 8, NTHR = 512;
constexpr int LDS_BYTES = 131072 + 256 + 16 * 1024;
#define LDS_WAIT() asm volatile("s_waitcnt lgkmcnt(0)" ::: "memory")

__device__ __forceinline__ void tr_item(const float* W, int K, int N, bf16_t* WT, const float* gain, int mode, LAS float* scr, int item, int lane) {
    const int nblk = N / 32, kb = item / nblk, nb = item % nblk, k0 = 64 * kb, n0 = 32 * nb;
    int ns = n0;
    if (mode) { const int t = n0 >> 8, j = n0 & 255;
        if (t < 4) ns = (j < 128) ? 128 * t + j : 512 + 128 * t + (j - 128);
        else if (t < 8) ns = (j < 128) ? 1536 + 128 * (t - 4) + j : 2048 + 128 * (t - 4) + (j - 128);
        else ns = 1024 + 256 * (t - 8) + j; }
#pragma unroll
    for (int i = 0; i < 32; ++i) { const int kk = 2 * i + (lane >> 5); const float gk = gain ? gain[k0 + kk] : 1.0f; scr[kk * 33 + (lane & 31)] = __builtin_nontemporal_load(W + (size_t)(k0 + kk) * N + ns + (lane & 31)) * gk; }
    LDS_WAIT(); asm volatile("" ::: "memory");
    const int c = lane & 7;
#pragma unroll
    for (int j = 0; j < 4; ++j) { const int n = (lane >> 3) + 8 * j; const LAS float* s = scr + (8 * c) * 33 + n;
        u32x4 o; o.x = cvt_pk_bf16(s[0 * 33], s[1 * 33]); o.y = cvt_pk_bf16(s[2 * 33], s[3 * 33]); o.z = cvt_pk_bf16(s[4 * 33], s[5 * 33]); o.w = cvt_pk_bf16(s[6 * 33], s[7 * 33]);
        *(u32x4*)(WT + (size_t)(n0 + n) * K + k0 + 8 * c) = o; }
    LDS_WAIT(); asm volatile("" ::: "memory");
}

struct Params { const float* in[21]; float* out; unsigned char* ws; };

constexpr int CR = 16;
template <int J, int I> __device__ __forceinline__ void conv_tap(f32x2 (&acc)[CR], const f32x2 (&w)[31], f32x2 x) {
    if constexpr (J - I >= 0 && J - I <= 30) acc[I] += w[J - I] * x;
}
template <int J, int... I> __device__ __forceinline__ void conv_row(f32x2 (&acc)[CR], const f32x2 (&w)[31], f32x2 x, std::integer_sequence<int, I...>) { (conv_tap<J, I>(acc, w, x), ...); }
template <int J> __device__ __forceinline__ void conv_j(f32x2 (&acc)[CR], const f32x2 (&w)[31], const unsigned (&xw)[CR + 30]) {
    const unsigned xv = xw[J];
    conv_row<J>(acc, w, (f32x2){bf_lo(xv), bf_hi(xv)}, std::make_integer_sequence<int, CR>{});
}
template <int... J> __device__ __forceinline__ void conv_all(f32x2 (&acc)[CR], const f32x2 (&w)[31], const unsigned (&xw)[CR + 30], std::integer_sequence<int, J...>) { (conv_j<J>(acc, w, xw), ...); }
template <int OFF, int... J> __device__ __forceinline__ void conv_load(unsigned (&xw)[CR + 30], const bf16_t* src, int tl, std::integer_sequence<int, J...>) {
    ((xw[OFF + J] = (tl - 30 + OFF + J >= 0) ? *(const unsigned*)(src + (size_t)(OFF + J) * NG1) : 0u), ...);
}
constexpr int CV_EARLY = 24;
__device__ __forceinline__ float xreduce16(const float (&v)[16], int lane) {
    float b[8], c[4], d[2], e;
    { const bool up = lane & 32;
#pragma unroll
      for (int i = 0; i < 8; ++i) { const float keep = up ? v[i + 8] : v[i], send = up ? v[i] : v[i + 8]; b[i] = keep + __shfl_xor(send, 32); } }
    { const bool up = lane & 16;
#pragma unroll
      for (int i = 0; i < 4; ++i) { const float keep = up ? b[i + 4] : b[i], send = up ? b[i] : b[i + 4]; c[i] = keep + __shfl_xor(send, 16); } }
    { const bool up = lane & 8;
#pragma unroll
      for (int i = 0; i < 2; ++i) { const float keep = up ? c[i + 2] : c[i], send = up ? c[i] : c[i + 2]; d[i] = keep + __shfl_xor(send, 8); } }
    { const bool up = lane & 4; const float keep = up ? d[1] : d[0], send = up ? d[0] : d[1]; e = keep + __shfl_xor(send, 4); }
    e += __shfl_xor(e, 2); e += __shfl_xor(e, 1);
    return e;
}

__device__ __forceinline__ void conv_phase(const Params& P, const bf16_t* G1, bf16_t* MX, LAS unsigned char* lds, int NGRP, int xg, int xr, int XR) {
    const float* caw = P.in[3]; const float* cab = P.in[4]; const float* lng = P.in[5]; const float* lnb = P.in[6]; const float* cbw = P.in[7];
    int tid_ = threadIdx.x; asm volatile("" : "+v"(tid_));
    const int tid = tid_, grp = tid >> 8, t8 = tid & 255, lane = tid & 63, wv = (tid >> 6) & 3;
    const int c0 = 2 * t8;
    LAS float* red = (LAS float*)lds;
    LAS float* st = (LAS float*)(lds + 4096);
    f32x2 w[31];
#pragma unroll
    for (int k = 0; k < 31; ++k) w[k] = *(const f32x2*)(caw + k * 512 + c0);
    const f32x2 cb = *(const f32x2*)(cab + c0), lg = *(const f32x2*)(lng + c0), lb = *(const f32x2*)(lnb + c0);
    const f32x2 wb0 = *(const f32x2*)(cbw + c0), wb1 = *(const f32x2*)(cbw + 512 + c0), wb2 = *(const f32x2*)(cbw + 1024 + c0);
    const int per_grp = (M / 32) / NGRP, nit = (per_grp - xr + XR - 1) / XR;
#define CV_BAR() do { asm volatile("s_waitcnt lgkmcnt(0)" ::: "memory"); __builtin_amdgcn_s_barrier(); asm volatile("" ::: "memory"); } while (0)
#define CV_T0(k_) ((xg * per_grp + xr + (nit - 1 - (k_)) * XR) * 32 + grp * CR)
#define CV_LOAD(XW, k_) do { const int t0_ = CV_T0(k_); conv_load<0>(XW, G1 + (size_t)(t0_ - 30) * NG1 + c0, t0_ & (SEQ - 1), std::make_integer_sequence<int, CV_EARLY>{}); } while (0)
#define CV_BODY(XW, k_) do { const int t0 = CV_T0(k_), tl = t0 & (SEQ - 1); \
        conv_load<CV_EARLY>(XW, G1 + (size_t)(t0 - 30) * NG1 + c0, tl, std::make_integer_sequence<int, CR + 30 - CV_EARLY>{}); \
        f32x2 acc[CR]; \
        _Pragma("unroll") for (int i = 0; i < CR; ++i) acc[i] = cb; \
        conv_all(acc, w, XW, std::make_integer_sequence<int, CR + 30>{}); \
        const bf16_t* ps = G1 + (size_t)t0 * NG1 + 512 + c0; const bf16_t* bg = G1 + (size_t)t0 * NG1 + 1024 + c0; \
        unsigned pa = 0u, pb = 0u; if (tl != 0) { pa = *(const unsigned*)(ps - 2 * (size_t)NG1); pb = *(const unsigned*)(ps - (size_t)NG1); } \
        float S, Q; \
        { float sv[CR]; _Pragma("unroll") for (int i = 0; i < CR; ++i) sv[i] = acc[i].x + acc[i].y; S = xreduce16(sv, lane); } \
        { float qv[CR]; _Pragma("unroll") for (int i = 0; i < CR; ++i) qv[i] = acc[i].x * acc[i].x + acc[i].y * acc[i].y; Q = xreduce16(qv, lane); } \
        if ((lane & 3) == 0) *(LAS f32x2*)(red + ((grp * 4 + wv) * CR + (lane >> 2)) * 2) = (f32x2){S, Q}; \
        CV_BAR(); \
        if (t8 < CR) { float s_ = 0.f, q_ = 0.f; \
            _Pragma("unroll") for (int x = 0; x < 4; ++x) { const f32x2 t = *(const LAS f32x2*)(red + ((grp * 4 + x) * CR + t8) * 2); s_ += t.x; q_ += t.y; } \
            const float mean = s_ * (1.0f / 512.0f), var = q_ * (1.0f / 512.0f) - mean * mean; \
            *(LAS f32x2*)(st + (grp * CR + t8) * 2) = (f32x2){mean, __builtin_amdgcn_rsqf(var + LN_EPS)}; } \
        CV_BAR(); \
        bf16_t* dst = MX + (size_t)t0 * D + c0; \
        _Pragma("unroll") for (int i = 0; i < CR; ++i) { const f32x2 ms = *(const LAS f32x2*)(st + (grp * CR + i) * 2); \
            const float y0 = (acc[i].x - ms.x) * ms.y * lg.x + lb.x, y1 = (acc[i].y - ms.x) * ms.y * lg.y + lb.y; \
            *(unsigned*)(dst + (size_t)i * D) = cvt_pk_bf16(y0 * fast_sigmoid(y0), y1 * fast_sigmoid(y1)); } \
          \
        float p2x = bf_lo(pa), p2y = bf_hi(pa), p1x = bf_lo(pb), p1y = bf_hi(pb); \
        _Pragma("unroll") for (int i = 0; i < CR; ++i) { const unsigned pvi = __builtin_nontemporal_load((const unsigned*)(ps + (size_t)i * NG1)), gvi = __builtin_nontemporal_load((const unsigned*)(bg + (size_t)i * NG1)); const float px = bf_lo(pvi), py = bf_hi(pvi); \
            const float ox = bf_lo(gvi) * (wb0.x * p2x + wb1.x * p1x + wb2.x * px), oy = bf_hi(gvi) * (wb0.y * p2y + wb1.y * p1y + wb2.y * py); \
            *(unsigned*)(dst + (size_t)i * D + 512) = cvt_pk_bf16(ox, oy); \
            p2x = p1x; p2y = p1y; p1x = px; p1y = py; } } while (0)
    unsigned xa[CR + 30], xb[CR + 30];
    if (nit > 0) CV_LOAD(xa, 0);
    for (int k = 0; k < nit; k += 2) {
        const bool has1 = k + 1 < nit, has2 = k + 2 < nit;
        if (has1) CV_LOAD(xb, k + 1);
        CV_BODY(xa, k);
        if (has1) { if (has2) CV_LOAD(xa, k + 2); CV_BODY(xb, k + 1); }
    }
#undef CV_BAR
#undef CV_T0
#undef CV_LOAD
#undef CV_BODY
}

constexpr int SG_STRIDE = 272, SG_TILE = 128 * SG_STRIDE, SG_STAT = 0, SG_GAIN = 16384, SG_TILES = 24576;
__device__ __forceinline__ void sgu_phase(const Params& P, const bf16_t* U, const bf16_t* V, bf16_t* Y, LAS unsigned char* lds, int NGRP, int xg, int xr, int XR) {
    const f32x2* VST = (const f32x2*)(P.ws + WS_VST); const bf16_t* WSB = (const bf16_t*)(P.ws + WS_WSB);
    const float* lvg = P.in[12]; const float* lvb = P.in[13]; const float* bs = P.in[15];
    int tid_ = threadIdx.x; asm volatile("" : "+v"(tid_));
    const int tid = tid_, wid = __builtin_amdgcn_readfirstlane(tid >> 6), lane = tid & 63, fr = lane & 15, fq = lane >> 4;
    const int wt = wid >> 1, wcn = wid & 1;
    LAS float* stat = (LAS float*)(lds + SG_STAT);
    LAS float* gain = (LAS float*)(lds + SG_GAIN);
    LAS unsigned char* tiles = lds + SG_TILES;
    const int lr = tid >> 4, lc = tid & 15;
    const int trb = ((lane & 15) >> 2) * SG_STRIDE + (lane & 3) * 8 + fq * 8 * SG_STRIDE + wcn * 128;
    const int per_grp = (M / 128) / NGRP, vblk = xg * per_grp + xr, G = XR;
    int nch = (per_grp - xr + XR - 1) / XR; if (nch > 16) nch = 16;
    const int NIT = nch * 8;
    for (int i = tid; i < nch * 128; i += NTHR) { const int row = (vblk + G * (i >> 7)) * 128 + (i & 127);
        const f32x4* p = (const f32x4*)(VST + (size_t)row * 16); float sm = 0.f, q = 0.f;
#pragma unroll
        for (int x = 0; x < 8; ++x) { const f32x4 t = p[x]; sm += t.x + t.z; q += t.y + t.w; }
        const float mean = sm * (1.0f / 1024.0f), var = q * (1.0f / 1024.0f) - mean * mean;
        *(LAS f32x2*)(stat + i * 2) = (f32x2){mean, __builtin_amdgcn_rsqf(var + LN_EPS)}; }
    for (int i = tid; i < 1024; i += NTHR) { gain[i] = lvg[i]; gain[1024 + i] = lvb[i]; }
    u32x4 vr[4]; bf16x8 af[2][4]; u32x2 ur[2][4]; float bsv[2];
#define SG_LOAD(n_, VR, AF, UR, BSV, LDA_) do { const int g_ = (n_) / nch, row0_ = (vblk + G * ((n_) - g_ * nch)) * 128; \
        _Pragma("unroll") for (int i = 0; i < 4; ++i) VR[i] = __builtin_nontemporal_load((const u32x4*)(V + (size_t)(row0_ + lr + 32 * i) * D + g_ * 128 + lc * 8)); \
        const bf16_t* wsg_ = WSB + (size_t)(g_ * 128 + 32 * wt + fr) * 128 + 8 * fq; \
        if (LDA_) { _Pragma("unroll") for (int mb = 0; mb < 2; ++mb) { _Pragma("unroll") for (int kk = 0; kk < 4; ++kk) AF[mb][kk] = *(const bf16x8*)(wsg_ + (size_t)(16 * mb) * 128 + 32 * kk); } } \
        _Pragma("unroll") for (int mb = 0; mb < 2; ++mb) { \
            const int tloc_ = 32 * wt + 16 * mb + fr; const size_t ro_ = (size_t)(row0_ + tloc_) * D + g_ * 128 + 64 * wcn + 4 * fq; BSV[mb] = bs[g_ * 128 + tloc_]; \
            _Pragma("unroll") for (int nb = 0; nb < 4; ++nb) UR[mb][nb] = __builtin_nontemporal_load((const u32x2*)(U + ro_ + 16 * nb)); } } while (0)
    SG_LOAD(0, vr, af, ur, bsv, true);
    __syncthreads();
    for (int n = 0; n < NIT; ++n) {
        const int g = n / nch, ci = n - g * nch, row0 = (vblk + G * ci) * 128;
        LAS unsigned char* tile = tiles + (n & 1) * SG_TILE;
        { const f32x4 g0 = *(const LAS f32x4*)(gain + g * 128 + lc * 8), g1 = *(const LAS f32x4*)(gain + g * 128 + lc * 8 + 4);
          const f32x4 b0 = *(const LAS f32x4*)(gain + 1024 + g * 128 + lc * 8), b1 = *(const LAS f32x4*)(gain + 1024 + g * 128 + lc * 8 + 4);
#pragma unroll
          for (int i = 0; i < 4; ++i) { const int rr = lr + 32 * i; const f32x2 ms = *(const LAS f32x2*)(stat + (ci * 128 + rr) * 2);
            const u32x4 raw = vr[i]; const float mu = ms.x, rs = ms.y;
            u32x4 o;
            o.x = cvt_pk_bf16((bf_lo(raw.x) - mu) * rs * g0[0] + b0[0], (bf_hi(raw.x) - mu) * rs * g0[1] + b0[1]);
            o.y = cvt_pk_bf16((bf_lo(raw.y) - mu) * rs * g0[2] + b0[2], (bf_hi(raw.y) - mu) * rs * g0[3] + b0[3]);
            o.z = cvt_pk_bf16((bf_lo(raw.z) - mu) * rs * g1[0] + b1[0], (bf_hi(raw.z) - mu) * rs * g1[1] + b1[1]);
            o.w = cvt_pk_bf16((bf_lo(raw.w) - mu) * rs * g1[2] + b1[2], (bf_hi(raw.w) - mu) * rs * g1[3] + b1[3]);
            *(LAS u32x4*)(tile + rr * SG_STRIDE + lc * 16) = o; } }
        __syncthreads();
        u32x4 vrn[4]; bf16x8 afn[2][4]; u32x2 urn[2][4]; float bsn[2];
        { const int nn = (n + 1 < NIT) ? n + 1 : n; const bool newg = (nn / nch) != g;
#pragma unroll
          for (int mb = 0; mb < 2; ++mb)
#pragma unroll
              for (int k = 0; k < 4; ++k) afn[mb][k] = af[mb][k];
          SG_LOAD(nn, vrn, afn, urn, bsn, newg); }
        f32x4 acc[2][4];
#pragma unroll
        for (int mb = 0; mb < 2; ++mb)
#pragma unroll
            for (int nb = 0; nb < 4; ++nb) acc[mb][nb] = (f32x4){0.f, 0.f, 0.f, 0.f};
#pragma unroll
        for (int kk = 0; kk < 4; ++kk) {
#pragma unroll
            for (int nb = 0; nb < 4; ++nb) {
                const LAS unsigned char* tp = tile + trb + kk * 32 * SG_STRIDE + nb * 32;
                const s16x4 lo = __builtin_amdgcn_ds_read_tr16_b64_v4i16((LAS s16x4*)(tp));
                const s16x4 hi = __builtin_amdgcn_ds_read_tr16_b64_v4i16((LAS s16x4*)(tp + 4 * SG_STRIDE));
                const bf16x8 bf = __builtin_shufflevector(lo, hi, 0, 1, 2, 3, 4, 5, 6, 7);
#pragma unroll
                for (int mb = 0; mb < 2; ++mb) acc[mb][nb] = __builtin_amdgcn_mfma_f32_16x16x32_bf16(bf, af[mb][kk], acc[mb][nb], 0, 0, 0);
            }
        }
#pragma unroll
        for (int mb = 0; mb < 2; ++mb) { const int tloc = 32 * wt + 16 * mb + fr;
            const size_t ro = (size_t)(row0 + tloc) * D + g * 128 + 64 * wcn + 4 * fq;
#pragma unroll
            for (int nb = 0; nb < 4; ++nb) { const u32x2 uv = ur[mb][nb]; const f32x4 a = acc[mb][nb]; const float bb = bsv[mb];
                u32x2 o; o.x = cvt_pk_bf16(bf_lo(uv.x) * (a[0] + bb), bf_hi(uv.x) * (a[1] + bb)); o.y = cvt_pk_bf16(bf_lo(uv.y) * (a[2] + bb), bf_hi(uv.y) * (a[3] + bb));
                *(u32x2*)(Y + ro + 16 * nb) = o; } }
#pragma unroll
        for (int i = 0; i < 4; ++i) vr[i] = vrn[i];
#pragma unroll
        for (int mb = 0; mb < 2; ++mb) { bsv[mb] = bsn[mb];
#pragma unroll
            for (int k = 0; k < 4; ++k) { af[mb][k] = afn[mb][k]; ur[mb][k] = urn[mb][k]; } }
    }
#undef SG_LOAD
}

#define XB_TMO      128
#define XB_XCNT(j)  (256  + 64 * (j))
#define XB_XSUB(j)  (1280 + 64 * (j))
#define XB_XGEN(j)  (2304 + 64 * (j))
#define XB_TOP      3328
#define XB_TOPGEN   3392
#define XB_LSUB(j)  (3456 + 64 * (j))
#define XB_PCNT(pm) (4480 + 16 * (pm))
#define XCD_BAR_WORDS (4480 + 16 * 128)
#define XB_SPIN_CAP (1u << 18)
__device__ __forceinline__ unsigned xb_ld(unsigned* p)              { return __hip_atomic_load(p, __ATOMIC_RELAXED, __HIP_MEMORY_SCOPE_AGENT); }
__device__ __forceinline__ unsigned xb_add(unsigned* p, unsigned v) { return __hip_atomic_fetch_add(p, v, __ATOMIC_RELAXED, __HIP_MEMORY_SCOPE_AGENT); }
__device__ __forceinline__ unsigned xb_xcc_id() { return (unsigned)__builtin_amdgcn_s_getreg((3 << 11) | 20) & 0xFu; }
#define XB_SPIN(cond, bar) do { unsigned _sp = 0; while (cond) { __builtin_amdgcn_s_sleep(1); \
    if ((++_sp & 255u) == 0u) { if (xb_ld(&(bar)[XB_TMO])) break; if (_sp > XB_SPIN_CAP) { atomicAdd(&(bar)[XB_TMO], 1u); break; } } } } while (0)
struct XcdBarrier { unsigned* bar; unsigned x; volatile LAS unsigned* st; };
__device__ __forceinline__ XcdBarrier xcd_barrier_post(unsigned* bar, volatile LAS unsigned* st) {
    XcdBarrier b; b.bar = bar; b.x = xb_xcc_id(); b.st = st;
    if (threadIdx.x == 0) st[2] = xb_add(&bar[XB_XCNT(b.x)], 1u);
    return b;
}
__device__ __forceinline__ void xcd_barrier_complete(unsigned* bar, unsigned x, unsigned& nloc, unsigned& nx) {
    const unsigned G = gridDim.x * gridDim.y * gridDim.z;
    unsigned sum, cnt, mine, sp = 0u;
    for (;;) {
        sum = 0u; cnt = 0u; mine = 0u;
#pragma unroll
        for (unsigned j = 0; j < 16; ++j) { const unsigned c = xb_ld(&bar[XB_XCNT(j)]); sum += c; cnt += (c > 0u) ? 1u : 0u; mine = (j == x) ? c : mine; }
        if (sum == G) break;
        __builtin_amdgcn_s_sleep(1);
        if ((++sp & 255u) == 0u) { if (xb_ld(&bar[XB_TMO])) break; if (sp > XB_SPIN_CAP) { atomicAdd(&bar[XB_TMO], 1u); break; } }
    }
    nloc = mine > 0u ? mine : 1u; nx = cnt > 0u ? cnt : 1u;
}
__device__ __forceinline__ void xcd_barrier(const XcdBarrier& b) {
    asm volatile("s_waitcnt vmcnt(0)" ::: "memory");
    __syncthreads();
    if (threadIdx.x == 0) {
        unsigned* bar = b.bar;
        __builtin_amdgcn_s_waitcnt(0);
        unsigned nloc = b.st[0], nx = b.st[1];
        if (nloc == 0u) { xcd_barrier_complete(bar, b.x, nloc, nx); b.st[0] = nloc; b.st[1] = nx; }
        const unsigned old = xb_add(&bar[XB_XSUB(b.x)], 1u);
        const unsigned gen = old / nloc;
        if (old + 1u == (gen + 1u) * nloc) {
            __builtin_amdgcn_fence(__ATOMIC_RELEASE, "agent");
            asm volatile("s_waitcnt vmcnt(0)" ::: "memory");
            const unsigned og = xb_add(&bar[XB_TOP], 1u);
            const unsigned tg = og / nx;
            if (og + 1u == (tg + 1u) * nx) xb_add(&bar[XB_TOPGEN], 1u);
            else XB_SPIN(xb_ld(&bar[XB_TOPGEN]) == tg, bar);
            __builtin_amdgcn_fence(__ATOMIC_ACQUIRE, "agent");
            xb_add(&bar[XB_XGEN(b.x)], 1u);
            asm volatile("s_waitcnt vmcnt(0)" ::: "memory");
        } else {
            XB_SPIN(xb_ld(&bar[XB_XGEN(b.x)]) == gen, bar);
            __builtin_amdgcn_fence(__ATOMIC_ACQUIRE, "agent");
            asm volatile("s_waitcnt vmcnt(0)" ::: "memory");
        }
    }
    __syncthreads();
}

__device__ __forceinline__ void xcd_local_barrier(const XcdBarrier& b, unsigned nloc) {
    asm volatile("s_waitcnt vmcnt(0)" ::: "memory");
    __syncthreads();
    if (threadIdx.x == 0) {
        unsigned* bar = b.bar;
        __builtin_amdgcn_s_waitcnt(0);
        const unsigned old = xb_add(&bar[XB_LSUB(b.x)], 1u);
        const unsigned target = (old / nloc + 1u) * nloc;
        XB_SPIN(xb_ld(&bar[XB_LSUB(b.x)]) < target, bar);
        __builtin_amdgcn_fence(__ATOMIC_ACQUIRE, "agent");
        asm volatile("s_waitcnt vmcnt(0)" ::: "memory");
    }
    __syncthreads();
}
__device__ __forceinline__ void xcd_classify(const XcdBarrier& b) {
    if (threadIdx.x == 0) {
        const unsigned G = gridDim.x; unsigned cnt = 0u, dense = 0u; bool uni = (G % 8u) == 0u;
#pragma unroll
        for (unsigned j = 0; j < 16; ++j) { const unsigned c = xb_ld(&b.bar[XB_XCNT(j)]); if (c > 0u) { ++cnt; if (c != G / 8u) uni = false; if (j < b.x) ++dense; } }
        b.st[3] = (uni && cnt == 8u) ? 1u : 0u; b.st[4] = dense;
    }
    __syncthreads();
}
__global__ void __launch_bounds__(NTHR, 2) fwd_megakernel(Params P) {
    extern __shared__ __attribute__((aligned(16))) unsigned char lds_raw[];
    LAS unsigned char* lds = (LAS unsigned char*)lds_raw;
    cg::grid_group grid = cg::this_grid();
    const int tid = threadIdx.x, lane = tid & 63, wave = __builtin_amdgcn_readfirstlane(tid >> 6);
    const int G = gridDim.x, bx = blockIdx.x;
    const int vblk = (G % 8 == 0) ? (bx % 8) * (G / 8) + bx / 8 : bx;
    const int NGRP0 = (G % 8 == 0) ? 8 : 1, xg0 = bx % NGRP0, xr0 = bx / NGRP0, XR0 = G / NGRP0;
    unsigned char* ws = P.ws;
    volatile LAS unsigned* misc = (volatile LAS unsigned*)(lds + 131072);
    if (tid < 16) misc[tid] = 0u;
    __syncthreads();
    const XcdBarrier xbar = xcd_barrier_post((unsigned*)(ws + WS_BAR), misc);
    bf16_t* XB = (bf16_t*)(ws + WS_XB);
    float* SS0 = (float*)(ws + WS_SS); float* SS1 = SS0 + (size_t)M * 16; float* SS2 = SS1 + (size_t)M * 16; float* SS3 = SS2 + (size_t)M * 16; float* SS4 = SS3 + (size_t)M * 16;
    bf16_t* WIN0 = (bf16_t*)(ws + WS_WIN0); bf16_t* WOUT0 = (bf16_t*)(ws + WS_WOUT0); bf16_t* W1_0 = (bf16_t*)(ws + WS_W1_0); bf16_t* W2_0 = (bf16_t*)(ws + WS_W2_0);
    bf16_t* WIN1 = (bf16_t*)(ws + WS_WIN1); bf16_t* WOUT1 = (bf16_t*)(ws + WS_WOUT1); bf16_t* W1_1 = (bf16_t*)(ws + WS_W1_1); bf16_t* W2_1 = (bf16_t*)(ws + WS_W2_1);

    {
        LAS float* scr = (LAS float*)(lds + wave * 16384);
        const int gw = vblk * NWAVES + wave, NGW = G * NWAVES;
        constexpr int I0 = 16 * 80, I1 = 16 * 32, I2 = 16 * 128, I3 = 64 * 32, I4 = 16 * 64, I5 = 16 * 32, I6 = 16 * 128, I7 = 64 * 32;
        constexpr int NITEMS = I0 + I1 + I2 + I3 + I4 + I5 + I6 + I7;
        for (int it = gw; it < NITEMS; it += NGW) {
            int r = it;
            if (r < I0) { tr_item(P.in[2], D, NIN0, WIN0, P.in[1], 1, scr, r, lane); continue; } r -= I0;
            if (r < I1) { tr_item(P.in[8], D, D, WOUT0, nullptr, 0, scr, r, lane); continue; } r -= I1;
            if (r < I2) { tr_item(P.in[18], D, FF, W1_0, P.in[17], 0, scr, r, lane); continue; } r -= I2;
            if (r < I3) { tr_item(P.in[19], FF, D, W2_0, nullptr, 0, scr, r, lane); continue; } r -= I3;
            if (r < I4) { tr_item(P.in[10], D, NIN1, WIN1, P.in[9], 0, scr, r, lane); continue; } r -= I4;
            if (r < I5) { tr_item(P.in[16], D, D, WOUT1, nullptr, 0, scr, r, lane); continue; } r -= I5;
            if (r < I6) { tr_item(P.in[18] + (size_t)D * FF, D, FF, W1_1, P.in[17] + D, 0, scr, r, lane); continue; } r -= I6;
            tr_item(P.in[19] + (size_t)FF * D, FF, D, W2_1, nullptr, 0, scr, r, lane);
        }
        { bf16_t* WSB = (bf16_t*)(ws + WS_WSB); const float* wsrc = P.in[14];
          for (int i = vblk * NTHR + tid; i < 8 * 128 * 128 / 2; i += G * NTHR) { const int e = 2 * i, s = e & 127, t = (e >> 7) & 127; const f32x2 v = *(const f32x2*)(wsrc + e);
              ((unsigned*)WSB)[i] = cvt_pk_bf16(s <= t ? v.x : 0.f, (s + 1) <= t ? v.y : 0.f); } }
        const float* x = P.in[0];
        const int RPG = M / NGRP0, rbase = xg0 * RPG, lw = xr0 * NWAVES + wave, LW = XR0 * NWAVES;
        for (int r0 = lw; r0 < RPG; r0 += 4 * LW) {
            f32x4 v[4][4];
#pragma unroll
            for (int u = 0; u < 4; ++u) { const int row = rbase + ((r0 + u * LW < RPG) ? r0 + u * LW : r0); const f32x4* xr = (const f32x4*)(x + (size_t)row * D) + lane;
#pragma unroll
                for (int j = 0; j < 4; ++j) v[u][j] = __builtin_nontemporal_load(xr + 64 * j); }
#pragma unroll
            for (int u = 0; u < 4; ++u) { const int row = rbase + r0 + u * LW; if (r0 + u * LW < RPG) { float s = 0.f;
#pragma unroll
                for (int j = 0; j < 4; ++j) { const f32x4 t = v[u][j]; s += (t.x * t.x + t.y * t.y) + (t.z * t.z + t.w * t.w);
                    u32x2 o; o.x = cvt_pk_bf16(t.x, t.y); o.y = cvt_pk_bf16(t.z, t.w); *(u32x2*)(XB + (size_t)row * D + 4 * lane + 256 * j) = o; }
                s += __shfl_xor(s, 1); s += __shfl_xor(s, 2);
                if ((lane & 3) == 0) SS0[(size_t)row * 16 + (lane >> 2)] = s; } }
        }
    }
    if (P.ws == nullptr) grid.sync();
    xcd_barrier(xbar);
    xcd_classify(xbar);
    const bool fast = misc[3] != 0u; const unsigned nloc = misc[0];
    const int NGRP = 8, xg = fast ? (int)misc[4] : bx % NGRP, xr = fast ? (int)misc[2] : bx / NGRP, XR = G / NGRP;
    const int cg_ = fast ? xr * 8 + xg : bx;
    bf16_t* const G1w = (bf16_t*)(ws + WS_R + (size_t)xg * (20 * MiB)); bf16_t* const Uw = (bf16_t*)(ws + WS_R + (size_t)xg * (24 * MiB));
    bf16_t* const Vw = (bf16_t*)(ws + WS_R + 8 * MiB + (size_t)xg * (24 * MiB)); bf16_t* const MXw = (bf16_t*)(ws + WS_R + 16 * MiB + (size_t)xg * (24 * MiB));
#define SEAM() do { if (fast) xcd_local_barrier(xbar, nloc); else xcd_barrier(xbar); } while (0)
    const LAS float* const rs_tab = (const LAS float*)(lds + pg8::STAGE_BYTES + 256);
    { pg8::Gemm g{XB, WIN0, M, NIN0, D}; pg8::StaticOrder S; S.init(M, NIN0, G, cg_); pg8::EpiInEven E{G1w, SS0, rs_tab};
      pg8::gemm_phase<pg8::EpiInEven, pg8::StaticOrder, true, true>(lds, g, S, E); }
    SEAM();
    conv_phase(P, G1w, MXw, lds, NGRP, xg, xr, XR);
    SEAM();
    { pg8::Gemm g{MXw, WOUT0, M, D, D}; pg8::StaticOrder S; S.init(M, D, G, cg_); pg8::EpiRes E{XB, XB, SS1};
      pg8::gemm_phase<pg8::EpiRes, pg8::StaticOrder, true, true>(lds, g, S, E); }
    SEAM();
    { pg8::Gemm g{XB, W1_0, M, FF, D}; pg8::StaticOrder S; S.init(M, FF, G, cg_); S.rev = 1; pg8::EpiHid E{(bf16_t*)(ws + WS_HID), SS1, rs_tab};
      pg8::gemm_phase<pg8::EpiHid, pg8::StaticOrder, true, true>(lds, g, S, E); }
    SEAM();
    { pg8::Gemm g{(const bf16_t*)(ws + WS_HID), W2_0, M, D, FF}; pg8::StaticOrder S; S.init(M, D, G, cg_);
      pg8::EpiRes E{XB, XB, SS2};
      pg8::gemm_phase<pg8::EpiRes, pg8::StaticOrder, true, true>(lds, g, S, E); }
    SEAM();
    { pg8::Gemm g{XB, WIN1, M, NIN1, D}; pg8::StaticOrder S; S.init(M, NIN1, G, cg_); S.rev = 1;
      pg8::EpiInOdd E{Uw, Vw, SS2, P.in[11], (f32x2*)(ws + WS_VST), rs_tab};
      pg8::gemm_phase<pg8::EpiInOdd, pg8::StaticOrder, true, true>(lds, g, S, E); }
    SEAM();
    sgu_phase(P, Uw, Vw, MXw, lds, NGRP, xg, xr, XR);
    SEAM();
    { pg8::Gemm g{MXw, WOUT1, M, D, D}; pg8::StaticOrder S; S.init(M, D, G, cg_);
      pg8::EpiRes E{XB, XB, SS3};
      pg8::gemm_phase<pg8::EpiRes, pg8::StaticOrder, true, true>(lds, g, S, E); }
    SEAM();
    { pg8::Gemm g{XB, W1_1, M, FF, D}; pg8::StaticOrder S; S.init(M, FF, G, cg_); S.rev = 1; pg8::EpiHid E{(bf16_t*)(ws + WS_HID), SS3, rs_tab};
      pg8::gemm_phase<pg8::EpiHid, pg8::StaticOrder, true, true>(lds, g, S, E); }
    SEAM();
    { pg8::Gemm g{(const bf16_t*)(ws + WS_HID), W2_1, M, D, FF}; pg8::StaticOrder S; S.init(M, D, G, cg_);
      unsigned* const bw = (unsigned*)(ws + WS_BAR);
      pg8::EpiResFinal E{XB, P.out, P.in[20], (unsigned*)(ws + 60 * MiB), bw + XB_PCNT(0), bw + XB_TMO, (LAS float*)(lds + pg8::STAGE_BYTES + 256)};
      pg8::gemm_phase<pg8::EpiResFinal, pg8::StaticOrder, true, true>(lds, g, S, E); }
}

extern "C" void kernel_launch(void* const* d_in, const int* in_sizes, int n_in, void* d_out, int out_size, void* d_ws, size_t ws_size, hipStream_t stream) {
    static int grid_blocks = 0;
    if (grid_blocks == 0) {
        if (n_in != 21 || in_sizes[0] != M * D || out_size != M * D || ws_size < WS_END) { fprintf(stderr, "kernel_launch: unexpected shapes (n_in %d in0 %d out %d ws %zu)\n", n_in, n_in > 0 ? in_sizes[0] : -1, out_size, ws_size); grid_blocks = -1; return; }
        int dev = 0, cus = 0, per_cu = 0;
        (void)hipGetDevice(&dev); (void)hipDeviceGetAttribute(&cus, hipDeviceAttributeMultiprocessorCount, dev);
        if (hipFuncSetAttribute((const void*)fwd_megakernel, hipFuncAttributeMaxDynamicSharedMemorySize, LDS_BYTES) != hipSuccess) { fprintf(stderr, "kernel_launch: hipFuncSetAttribute failed\n"); grid_blocks = -1; return; }
        if (hipOccupancyMaxActiveBlocksPerMultiprocessor(&per_cu, (const void*)fwd_megakernel, NTHR, LDS_BYTES) != hipSuccess || per_cu < 1) { fprintf(stderr, "kernel_launch: occupancy query says %d\n", per_cu); per_cu = 1; }
        (void)hipGetLastError();
        if (cus % 8 != 0 || cus < 128) { fprintf(stderr, "kernel_launch: needs a CU count that is a multiple of 8 and >= 128 (got %d)\n", cus); grid_blocks = -1; return; }
        grid_blocks = cus * 1;
    }
    if (grid_blocks < 0) return;
    if (hipMemsetAsync((char*)d_ws + WS_BAR, 0, XCD_BAR_WORDS * 4, stream) != hipSuccess) { fprintf(stderr, "kernel_launch: memset of the barrier words failed\n"); return; }
    Params p{};
    for (int i = 0; i < 21; ++i) p.in[i] = (const float*)d_in[i];
    p.out = (float*)d_out; p.ws = (unsigned char*)d_ws;
    void* args[] = {&p};
    hipError_t e = hipLaunchCooperativeKernel((const void*)fwd_megakernel, dim3(grid_blocks), dim3(NTHR), args, LDS_BYTES, stream);
    if (e != hipSuccess) fprintf(stderr, "cooperative launch failed: %s (grid %d)\n", hipGetErrorString(e), grid_blocks);
}
```

```cpp
#include <hip/hip_runtime.h>
#include <hip/hip_cooperative_groups.h>
#include <cstdio>
#include <utility>
namespace cg = cooperative_groups;

#define LAS __attribute__((address_space(3)))
typedef unsigned short bf16_t;
typedef short bf16x8 __attribute__((ext_vector_type(8)));
typedef short s16x4 __attribute__((ext_vector_type(4)));
typedef float f32x4 __attribute__((ext_vector_type(4)));
typedef float f32x2 __attribute__((ext_vector_type(2)));
typedef unsigned u32x4 __attribute__((ext_vector_type(4)));
typedef unsigned u32x2 __attribute__((ext_vector_type(2)));

constexpr int D = 1024, SEQ = 2048, M = 16 * 2048, FF = 4096, NIN0 = 2560, NG1 = 1536, NIN1 = 2048;
constexpr float RMS_EPS = 1e-6f, LN_EPS = 1e-5f;
constexpr size_t MiB = 1u << 20;
constexpr size_t WS_WIN0 = 0, WS_WOUT0 = 5 * MiB, WS_W1_0 = 7 * MiB, WS_W2_0 = 15 * MiB, WS_WIN1 = 23 * MiB, WS_WOUT1 = 27 * MiB, WS_W1_1 = 29 * MiB, WS_W2_1 = 37 * MiB, WS_WSB = 45 * MiB;
constexpr size_t WS_SS = 46 * MiB  , WS_VST = 56 * MiB  , WS_XB = 64 * MiB  ;
constexpr size_t WS_R = 128 * MiB  , WS_HID = WS_R, WS_END = 384 * MiB, WS_BAR = 62 * MiB;

__device__ __forceinline__ unsigned cvt_pk_bf16(float lo, float hi) { unsigned r; asm volatile("v_cvt_pk_bf16_f32 %0, %1, %2" : "=v"(r) : "v"(lo), "v"(hi)); return r; }
__device__ __forceinline__ float bf_lo(unsigned v) { return __builtin_bit_cast(float, v << 16); }
__device__ __forceinline__ float bf_hi(unsigned v) { return __builtin_bit_cast(float, v & 0xffff0000u); }
__device__ __forceinline__ float relu1(float x) { float r; asm("v_max_f32_e32 %0, 0, %1" : "=v"(r) : "v"(x)); return r; }
__device__ __forceinline__ float fast_sigmoid(float x) { return __builtin_amdgcn_rcpf(1.0f + __builtin_amdgcn_exp2f(x * -1.44269504089f)); }

namespace pg8 {
constexpr int BM = 256, BK = 64, HALF = 128, HTB = HALF * BK * 2, STAGE_BYTES = 8 * HTB, NXCD = 8, WGM = 8;
__host__ __device__ __forceinline__ int lds_byte(int r, int c) { const int st = (r >> 4) * 2 + (c >> 5), rr = r & 15, cc = c & 31, ob = rr * 64 + cc * 2; return st * 1024 + (ob ^ (((ob >> 9) & 1) << 5)); }
__host__ __device__ __forceinline__ void stage_rc(int b, int& R, int& C) { const int st = b / 1024, sb = b % 1024, swz = sb ^ (((sb >> 9) & 1) << 5); R = (st >> 1) * 16 + swz / 64; C = (st & 1) * 32 + (swz % 64) / 2; }
__host__ __device__ __forceinline__ int perm32(int rho) { const int n = rho >> 4, i = rho & 15; return 8 * (i >> 2) + 4 * n + (i & 3); }
struct Unit { int pm, pn; };
struct Gemm { const bf16_t* A; const bf16_t* Bt; int M, N, K; };
struct StaticOrder {
    int nM, nN, nwg, G, c;
    __device__ void init(int M_, int N_, int G_, int c_) { nM = M_ / BM; nN = N_ / BM; nwg = nM * nN; G = G_; c = c_; }
    __device__ bool next(int i, Unit& u) const {
        const long L = (long)i * G + c; if (L >= nwg) return false;
        int wgid = (int)L; { const int q = nwg / NXCD, r = nwg % NXCD, xcd = wgid % NXCD, off = wgid / NXCD; wgid = (xcd < r ? xcd * (q + 1) : r * (q + 1) + (xcd - r) * q) + off; }
        const int nig = WGM * nN, gid = wgid / nig, fm = gid * WGM, gsz = (nM - fm) < WGM ? (nM - fm) : WGM;
        u.pm = fm + ((wgid % nig) % gsz); u.pn = (wgid % nig) / gsz; return true;
    }
};
__device__ __forceinline__ f32x2 gelu_pk(f32x2 v) {
    const f32x2 av = __builtin_elementwise_abs(v), d = av * 0.2316418882f + 1.0f;
    f32x2 t; t.x = __builtin_amdgcn_rcpf(d.x); t.y = __builtin_amdgcn_rcpf(d.y);
    f32x2 q = t * 0.5307027145f + (-0.7265760135f); q = q * t + 0.7107068705f; q = q * t + (-0.142248368f); q = q * t + 0.127414796f; q = q * t;
    const f32x2 s = (v * v) * (-0.72134752044f);
    f32x2 e; e.x = __builtin_amdgcn_exp2f(s.x); e.y = __builtin_amdgcn_exp2f(s.y);
    const f32x2 m = v * (q * e), r = v - m;
    f32x2 o; o.x = v.x < 0.f ? m.x : r.x; o.y = v.y < 0.f ? m.y : r.y; return o;
}
__device__ __forceinline__ float row_rs(const float* ss, int row) {
    const f32x4* p = (const f32x4*)(ss + (size_t)row * 16); f32x4 a = p[0], b = p[1], c = p[2], d = p[3]; a = (a + b) + (c + d);
    return __builtin_amdgcn_rsqf(((a.x + a.y) + (a.z + a.w)) * (1.0f / 1024.0f) + RMS_EPS);
}

struct EpiInEven {
    static constexpr bool PERM = true, AFTER_DRAIN = false;
    static constexpr bool NEEDS_RS = true;
    bf16_t* G1; const float* ss; const LAS float* rs_tab;
    __device__ __forceinline__ void operator()(const f32x4 (&acc)[2][2][4][2], const Unit& u, int ui, int wr, int wc, int fr, int fq) const {
        const LAS float* rsp = rs_tab + ui * 256 + wr * 64 + fr; float rsv[2][4];
#pragma unroll
        for (int ai = 0; ai < 2; ++ai)
#pragma unroll
            for (int m = 0; m < 4; ++m) rsv[ai][m] = rsp[ai * HALF + m * 16];
        const int row0 = u.pm * BM + wr * 64 + fr;
#pragma unroll
        for (int ai = 0; ai < 2; ++ai)
#pragma unroll
            for (int m = 0; m < 4; ++m) {
                const int row = row0 + ai * HALF + m * 16; const float r = rsv[ai][m];
                bf16_t* rowp = G1 + (size_t)row * NG1 + wc * 32 + 8 * fq;
                if (u.pn < 4) {
                    f32x4 v0 = acc[ai][0][m][0] * r, v1 = acc[ai][0][m][1] * r, g0 = acc[ai][1][m][0] * r, g1 = acc[ai][1][m][1] * r;
#pragma unroll
                    for (int j = 0; j < 4; ++j) { v0[j] *= fast_sigmoid(g0[j]); v1[j] *= fast_sigmoid(g1[j]); }
                    u32x4 w; w.x = cvt_pk_bf16(v0[0], v0[1]); w.y = cvt_pk_bf16(v0[2], v0[3]); w.z = cvt_pk_bf16(v1[0], v1[1]); w.w = cvt_pk_bf16(v1[2], v1[3]);
                    *(u32x4*)(rowp + 128 * u.pn) = w;
                } else if (u.pn < 8) {
                    const float r2 = r * r; f32x4 v0 = acc[ai][0][m][0] * acc[ai][1][m][0] * r2, v1 = acc[ai][0][m][1] * acc[ai][1][m][1] * r2;
                    u32x4 w; w.x = cvt_pk_bf16(v0[0], v0[1]); w.y = cvt_pk_bf16(v0[2], v0[3]); w.z = cvt_pk_bf16(v1[0], v1[1]); w.w = cvt_pk_bf16(v1[2], v1[3]);
                    *(u32x4*)(rowp + 512 + 128 * (u.pn - 4)) = w;
                } else {
#pragma unroll
                    for (int bj = 0; bj < 2; ++bj) { f32x4 v0 = acc[ai][bj][m][0] * r, v1 = acc[ai][bj][m][1] * r;
                        u32x4 w; w.x = cvt_pk_bf16(v0[0], v0[1]); w.y = cvt_pk_bf16(v0[2], v0[3]); w.z = cvt_pk_bf16(v1[0], v1[1]); w.w = cvt_pk_bf16(v1[2], v1[3]);
                        *(u32x4*)(rowp + 1024 + 256 * (u.pn - 8) + 128 * bj) = w; }
                }
            }
    }
};
struct EpiRes {
    static constexpr bool PERM = true, AFTER_DRAIN = false;
    static constexpr bool NEEDS_RS = false;
    const bf16_t* res; bf16_t* XB; float* ssout;
    __device__ __forceinline__ void operator()(const f32x4 (&acc)[2][2][4][2], const Unit& u, int ui, int wr, int wc, int fr, int fq) const {
        const int row0 = u.pm * BM + wr * 64 + fr, col0 = u.pn * BM + wc * 32 + 8 * fq;
        u32x4 rv[2][4][2];
#pragma unroll
        for (int ai = 0; ai < 2; ++ai)
#pragma unroll
            for (int m = 0; m < 4; ++m)
#pragma unroll
                for (int bj = 0; bj < 2; ++bj) rv[ai][m][bj] = *(const u32x4*)(res + (size_t)(row0 + ai * HALF + m * 16) * D + col0 + bj * HALF);
#pragma unroll
        for (int ai = 0; ai < 2; ++ai) {
#pragma unroll
            for (int m = 0; m < 4; ++m) {
                const int row = row0 + ai * HALF + m * 16; const size_t off = (size_t)row * D + col0; float q = 0.f;
#pragma unroll
                for (int bj = 0; bj < 2; ++bj) {
                    const u32x4 r = rv[ai][m][bj];
                    const f32x4 h0 = (f32x4){bf_lo(r.x), bf_hi(r.x), bf_lo(r.y), bf_hi(r.y)} + acc[ai][bj][m][0], h1 = (f32x4){bf_lo(r.z), bf_hi(r.z), bf_lo(r.w), bf_hi(r.w)} + acc[ai][bj][m][1];
                    q += (h0[0] * h0[0] + h0[1] * h0[1]) + (h0[2] * h0[2] + h0[3] * h0[3]) + (h1[0] * h1[0] + h1[1] * h1[1]) + (h1[2] * h1[2] + h1[3] * h1[3]);
                    u32x4 w; w.x = cvt_pk_bf16(h0[0], h0[1]); w.y = cvt_pk_bf16(h0[2], h0[3]); w.z = cvt_pk_bf16(h1[0], h1[1]); w.w = cvt_pk_bf16(h1[2], h1[3]);
                    *(u32x4*)(XB + off + bj * HALF) = w;
                }
                q += __shfl_xor(q, 16); q += __shfl_xor(q, 32);
                if (fq == 0) ssout[(size_t)row * 16 + u.pn * 4 + wc] = q;
            }
            asm volatile("" ::: "memory");
        }
    }
};
struct EpiResFinal {
    static constexpr bool PERM = true, AFTER_DRAIN = false, NEEDS_RS = false;
    const bf16_t* res; float* out; const float* gfin; unsigned* xq; unsigned* cnt; unsigned* tmo; LAS float* sl;
    __device__ __forceinline__ void operator()(f32x4 (&acc)[2][2][4][2], const Unit& u, int ui, int wr, int wc, int fr, int fq) const {
        const int row0 = u.pm * BM + wr * 64 + fr, col0 = u.pn * BM + wc * 32 + 8 * fq, tid = threadIdx.x;
        LAS float* part = sl; LAS float* rsT = sl + 1024;
#pragma unroll
        for (int ai = 0; ai < 2; ++ai) {
            u32x4 rv[4][2];
#pragma unroll
            for (int m = 0; m < 4; ++m)
#pragma unroll
                for (int bj = 0; bj < 2; ++bj) rv[m][bj] = *(const u32x4*)(res + (size_t)(row0 + ai * HALF + m * 16) * D + col0 + bj * HALF);
#pragma unroll
            for (int m = 0; m < 4; ++m) { float q = 0.f;
#pragma unroll
                for (int bj = 0; bj < 2; ++bj) { const u32x4 r = rv[m][bj];
                    const f32x4 h0 = (f32x4){bf_lo(r.x), bf_hi(r.x), bf_lo(r.y), bf_hi(r.y)} + acc[ai][bj][m][0], h1 = (f32x4){bf_lo(r.z), bf_hi(r.z), bf_lo(r.w), bf_hi(r.w)} + acc[ai][bj][m][1];
                    q += (h0[0] * h0[0] + h0[1] * h0[1]) + (h0[2] * h0[2] + h0[3] * h0[3]) + (h1[0] * h1[0] + h1[1] * h1[1]) + (h1[2] * h1[2] + h1[3] * h1[3]);
                    acc[ai][bj][m][0] = h0; acc[ai][bj][m][1] = h1; }
                q += __shfl_xor(q, 16); q += __shfl_xor(q, 32);
                if (fq == 0) part[(ai * HALF + wr * 64 + m * 16 + fr) * 4 + wc] = q; }
        }
        asm volatile("s_waitcnt lgkmcnt(0)" ::: "memory"); __builtin_amdgcn_s_barrier(); asm volatile("" ::: "memory");
        if (tid < 256) { const f32x4 p = *(const LAS f32x4*)(part + tid * 4);
            __hip_atomic_store(xq + (size_t)(u.pm * BM + tid) * 4 + u.pn, __builtin_bit_cast(unsigned, (p.x + p.y) + (p.z + p.w)), __ATOMIC_RELAXED, __HIP_MEMORY_SCOPE_AGENT); }
        asm volatile("s_waitcnt vmcnt(0)" ::: "memory"); __builtin_amdgcn_s_barrier(); asm volatile("" ::: "memory");
        if (tid == 0) { unsigned* c = cnt + 16 * u.pm; __hip_atomic_fetch_add(c, 1u, __ATOMIC_RELAXED, __HIP_MEMORY_SCOPE_AGENT);
            unsigned sp = 0u;
            while (__hip_atomic_load(c, __ATOMIC_RELAXED, __HIP_MEMORY_SCOPE_AGENT) < 4u) { __builtin_amdgcn_s_sleep(1);
                if ((++sp & 255u) == 0u) { if (__hip_atomic_load(tmo, __ATOMIC_RELAXED, __HIP_MEMORY_SCOPE_AGENT)) break; if (sp > (1u << 18)) { atomicAdd(tmo, 1u); break; } } }
            __builtin_amdgcn_fence(__ATOMIC_ACQUIRE, "agent"); asm volatile("s_waitcnt vmcnt(0)" ::: "memory"); }
        __builtin_amdgcn_s_barrier(); asm volatile("" ::: "memory");
        if (tid < 256) { const unsigned* p = xq + (size_t)(u.pm * BM + tid) * 4; float sm = 0.f;
#pragma unroll
            for (int t = 0; t < 4; ++t) sm += __builtin_bit_cast(float, __hip_atomic_load(p + t, __ATOMIC_RELAXED, __HIP_MEMORY_SCOPE_AGENT));
            rsT[tid] = __builtin_amdgcn_rsqf(sm * (1.0f / 1024.0f) + RMS_EPS); }
        asm volatile("s_waitcnt lgkmcnt(0)" ::: "memory"); __builtin_amdgcn_s_barrier(); asm volatile("" ::: "memory");
        f32x4 gv[2][2];
#pragma unroll
        for (int bj = 0; bj < 2; ++bj)
#pragma unroll
            for (int n = 0; n < 2; ++n) gv[bj][n] = *(const f32x4*)(gfin + col0 + bj * HALF + 4 * n);
#pragma unroll
        for (int ai = 0; ai < 2; ++ai)
#pragma unroll
            for (int m = 0; m < 4; ++m) { const int rl = ai * HALF + wr * 64 + m * 16 + fr; const float r = rsT[rl]; float* orow = out + (size_t)(u.pm * BM + rl) * D + col0;
#pragma unroll
                for (int bj = 0; bj < 2; ++bj)
#pragma unroll
                    for (int n = 0; n < 2; ++n) *(f32x4*)(orow + bj * HALF + 4 * n) = acc[ai][bj][m][n] * r * gv[bj][n]; }
    }
};
struct EpiHid {
    static constexpr bool PERM = true, AFTER_DRAIN = false;
    static constexpr bool NEEDS_RS = true;
    bf16_t* O; const float* ss; const LAS float* rs_tab;
    __device__ __forceinline__ void operator()(const f32x4 (&acc)[2][2][4][2], const Unit& u, int ui, int wr, int wc, int fr, int fq) const {
        const LAS float* rsp = rs_tab + ui * 256 + wr * 64 + fr; float rsv[2][4];
#pragma unroll
        for (int ai = 0; ai < 2; ++ai)
#pragma unroll
            for (int m = 0; m < 4; ++m) rsv[ai][m] = rsp[ai * HALF + m * 16];
        const int row0 = u.pm * BM + wr * 64 + fr, col0 = u.pn * BM + wc * 32 + 8 * fq;
#pragma unroll
        for (int ai = 0; ai < 2; ++ai)
#pragma unroll
            for (int m = 0; m < 4; ++m) {
                const int row = row0 + ai * HALF + m * 16; const float r = rsv[ai][m], r2 = r * r;
                bf16_t* rowp = O + (size_t)row * FF + col0;
#pragma unroll
                for (int bj = 0; bj < 2; ++bj) {
                    f32x4 v0, v1;
#pragma unroll
                    for (int j = 0; j < 4; ++j) { v0[j] = relu1(acc[ai][bj][m][0][j]); v1[j] = relu1(acc[ai][bj][m][1][j]); }
                    v0 = v0 * v0 * r2; v1 = v1 * v1 * r2;
                    u32x4 w; w.x = cvt_pk_bf16(v0[0], v0[1]); w.y = cvt_pk_bf16(v0[2], v0[3]); w.z = cvt_pk_bf16(v1[0], v1[1]); w.w = cvt_pk_bf16(v1[2], v1[3]);
                    __builtin_nontemporal_store(w, (u32x4*)(rowp + bj * HALF)); }
            }
    }
};
struct EpiInOdd {
    static constexpr bool PERM = true, AFTER_DRAIN = false;
    static constexpr bool NEEDS_RS = true;
    bf16_t* U; bf16_t* V; const float* ss; const float* bias; f32x2* vst; const LAS float* rs_tab;
    __device__ __forceinline__ void operator()(const f32x4 (&acc)[2][2][4][2], const Unit& u, int ui, int wr, int wc, int fr, int fq) const {
        const LAS float* rsp = rs_tab + ui * 256 + wr * 64 + fr; float rsv[2][4];
#pragma unroll
        for (int ai = 0; ai < 2; ++ai)
#pragma unroll
            for (int m = 0; m < 4; ++m) rsv[ai][m] = rsp[ai * HALF + m * 16];
        const int row0 = u.pm * BM + wr * 64 + fr, colt = wc * 32 + 8 * fq; const bool isv = u.pn >= 4;
        bf16_t* base = isv ? V : U; const int col0 = (isv ? u.pn - 4 : u.pn) * BM + colt;
        f32x4 bv[2][2];
#pragma unroll
        for (int bj = 0; bj < 2; ++bj)
#pragma unroll
            for (int n = 0; n < 2; ++n) bv[bj][n] = *(const f32x4*)(bias + u.pn * BM + colt + bj * HALF + 4 * n);
#pragma unroll
        for (int ai = 0; ai < 2; ++ai)
#pragma unroll
            for (int m = 0; m < 4; ++m) {
                const int row = row0 + ai * HALF + m * 16; const float r = rsv[ai][m]; float s = 0.f, q = 0.f;
                bf16_t* rowp = base + (size_t)row * D + col0;
#pragma unroll
                for (int bj = 0; bj < 2; ++bj) {
                    f32x4 v0 = acc[ai][bj][m][0] * r + bv[bj][0], v1 = acc[ai][bj][m][1] * r + bv[bj][1];
                    f32x2 a = gelu_pk((f32x2){v0[0], v0[1]}), b = gelu_pk((f32x2){v0[2], v0[3]}), c = gelu_pk((f32x2){v1[0], v1[1]}), d = gelu_pk((f32x2){v1[2], v1[3]});
                    s += (a.x + a.y) + (b.x + b.y) + (c.x + c.y) + (d.x + d.y);
                    q += (a.x * a.x + a.y * a.y) + (b.x * b.x + b.y * b.y) + (c.x * c.x + c.y * c.y) + (d.x * d.x + d.y * d.y);
                    u32x4 w; w.x = cvt_pk_bf16(a.x, a.y); w.y = cvt_pk_bf16(b.x, b.y); w.z = cvt_pk_bf16(c.x, c.y); w.w = cvt_pk_bf16(d.x, d.y);
                    *(u32x4*)(rowp + bj * HALF) = w; }
                if (isv) { s += __shfl_xor(s, 16); s += __shfl_xor(s, 32); q += __shfl_xor(q, 16); q += __shfl_xor(q, 32);
                    if (fq == 0) vst[(size_t)row * 16 + (u.pn - 4) * 4 + wc] = (f32x2){s, q}; }
            }
    }
};

template <class Epi, class Sched, bool ALIGN_EPI = false, bool SP2 = false>
__device__ __forceinline__ void gemm_phase(LAS unsigned char* lds, const Gemm g, const Sched& S, const Epi& E) {
    int tid_ = threadIdx.x; asm volatile("" : "+v"(tid_));
    const int tid = tid_, wid = __builtin_amdgcn_readfirstlane(tid >> 6), lane = tid & 63, wr = wid >> 2, wc = wid & 3, fr = lane & 15, fq = lane >> 4;
    const int K = g.K, nt = K / BK;
    unsigned voffA[2], voffB[2];
#pragma unroll
    for (int i = 0; i < 2; ++i) { int R, C; stage_rc(tid * 16 + i * 8192, R, C); const int Rb = Epi::PERM ? ((R & ~31) + perm32(R & 31)) : R;
        voffA[i] = (unsigned)(R * K + C) * 2u; voffB[i] = (unsigned)(Rb * K + C) * 2u; }
    const size_t kstep = (size_t)(BK * 2);
    const size_t hstep = (size_t)HALF * K * 2;
    const size_t tstep = 2 * hstep;
    const unsigned ldsw = (unsigned)wid * 1024u;
    const int aoff = lds_byte(wr * 64 + fr, fq * 8), boff = lds_byte(wc * 32 + fr, fq * 8);
#define PG8_SA(b, h) (((b) * 2 + (h)) * HTB)
#define PG8_SB(b, h) ((4 + (b) * 2 + (h)) * HTB)
#define PG8_STAGE(bufoff, gbase, voff) do { _Pragma("unroll") for (int _i = 0; _i < 2; ++_i) \
        __builtin_amdgcn_global_load_lds((const unsigned*)((const char*)(gbase) + (voff)[_i]), (LAS unsigned*)(lds + (bufoff) + ldsw + _i * 8192), 16, 0, 0); } while (0)
#define PG8_LDA(dst, b, h) do { _Pragma("unroll") for (int m = 0; m < 4; ++m) _Pragma("unroll") for (int k = 0; k < 2; ++k) dst[m][k] = *(const LAS bf16x8*)(lds + PG8_SA(b, h) + aoff + m * 2048 + k * 1024); } while (0)
#define PG8_LDB(dst, b, h) do { _Pragma("unroll") for (int n = 0; n < 2; ++n) _Pragma("unroll") for (int k = 0; k < 2; ++k) dst[n][k] = *(const LAS bf16x8*)(lds + PG8_SB(b, h) + boff + n * 2048 + k * 1024); } while (0)
#define PG8_MMA(ai, bj, At, Bt) do { __builtin_amdgcn_s_setprio(1); _Pragma("unroll") for (int m = 0; m < 4; ++m) _Pragma("unroll") for (int n = 0; n < 2; ++n) _Pragma("unroll") for (int k = 0; k < 2; ++k) \
        acc[ai][bj][m][n] = __builtin_amdgcn_mfma_f32_16x16x32_bf16(Bt[n][k], At[m][k], acc[ai][bj][m][n], 0, 0, 0); __builtin_amdgcn_s_setprio(0); } while (0)
#define PG8_WAIT_V(n) asm volatile("s_waitcnt vmcnt(" #n ")" ::: "memory")
#define PG8_WAIT_L(n) asm volatile("s_waitcnt lgkmcnt(" #n ")" ::: "memory")
#define PG8_BAR __builtin_amdgcn_s_barrier()
#define PG8_SCHED __builtin_amdgcn_sched_barrier(0)
    Unit cur, nxt; int ui = 0;
    if (!S.next(0, cur)) return;
    f32x4 acc[2][2][4][2];
#pragma unroll
    for (int a = 0; a < 2; ++a)
#pragma unroll
        for (int b = 0; b < 2; ++b)
#pragma unroll
            for (int m = 0; m < 4; ++m)
#pragma unroll
                for (int n = 0; n < 2; ++n) acc[a][b][m][n] = (f32x4){0.f, 0.f, 0.f, 0.f};
    bf16x8 At[4][2], B0[2][2], B1[2][2];
    const char* cA = (const char*)g.A + (size_t)cur.pm * tstep; const char* cB = (const char*)g.Bt + (size_t)cur.pn * tstep;
    if constexpr (SP2) {
        PG8_STAGE(PG8_SB(0, 0), cB, voffB); PG8_STAGE(PG8_SB(0, 1), cB + hstep, voffB); PG8_STAGE(PG8_SA(0, 0), cA, voffA); PG8_STAGE(PG8_SA(0, 1), cA + hstep, voffA);
        if constexpr (Epi::NEEDS_RS) {
            LAS float* tab = (LAS float*)(lds + STAGE_BYTES + 256); Unit pu;
            for (int i = tid >> 8; S.next(i, pu); i += 2) tab[i * 256 + (tid & 255)] = row_rs(E.ss, pu.pm * BM + (tid & 255));
            PG8_WAIT_L(0);
        }
        if (wr == 1) PG8_BAR;
        PG8_WAIT_V(2); PG8_BAR;
        PG8_STAGE(PG8_SB(1, 0), cB + kstep, voffB); PG8_STAGE(PG8_SA(1, 0), cA + kstep, voffA); PG8_STAGE(PG8_SB(1, 1), cB + hstep + kstep, voffB);
        PG8_WAIT_V(6); PG8_BAR;
    } else {
        PG8_STAGE(PG8_SB(0, 0), cB, voffB); PG8_STAGE(PG8_SA(0, 0), cA, voffA); PG8_STAGE(PG8_SB(0, 1), cB + hstep, voffB); PG8_STAGE(PG8_SA(0, 1), cA + hstep, voffA);
        if (wr == 1) PG8_BAR;
        PG8_WAIT_V(4); PG8_BAR;
        PG8_STAGE(PG8_SB(1, 0), cB + kstep, voffB); PG8_STAGE(PG8_SA(1, 0), cA + kstep, voffA); PG8_STAGE(PG8_SB(1, 1), cB + hstep + kstep, voffB);
        PG8_WAIT_V(6); PG8_BAR;
    }
    for (;;) {
        const bool has_next = S.next(ui + 1, nxt);
        const char* nA = has_next ? (const char*)g.A + (size_t)nxt.pm * tstep : cA; const char* nB = has_next ? (const char*)g.Bt + (size_t)nxt.pn * tstep : cB;
        for (int t = 0; t < nt; t += 2) {
            const bool last = (t == nt - 2);
            const char* a1 = cA + (size_t)(t + 1) * kstep;
            const char* a2 = last ? nA : cA + (size_t)(t + 2) * kstep; const char* b2 = last ? nB : cB + (size_t)(t + 2) * kstep;
            const char* a3 = a2 + kstep; const char* b3 = b2 + kstep;
            if constexpr (SP2) {
            PG8_LDB(B0, 0, 0); PG8_LDB(B1, 0, 1); PG8_SCHED; PG8_LDA(At, 0, 0); PG8_STAGE(PG8_SA(1, 1), a1 + hstep, voffA);
            PG8_WAIT_V(8); PG8_WAIT_L(0); PG8_BAR; PG8_MMA(0, 0, At, B0); PG8_MMA(0, 1, At, B1); PG8_BAR; PG8_SCHED;
            PG8_LDA(At, 0, 1); PG8_STAGE(PG8_SB(0, 0), b2, voffB); PG8_STAGE(PG8_SB(0, 1), b2 + hstep, voffB); PG8_STAGE(PG8_SA(0, 0), a2, voffA);
            PG8_WAIT_V(8); PG8_WAIT_L(0); PG8_BAR; PG8_MMA(1, 0, At, B0); PG8_MMA(1, 1, At, B1); PG8_BAR; PG8_SCHED;
            PG8_LDB(B0, 1, 0); PG8_LDB(B1, 1, 1); PG8_SCHED; PG8_LDA(At, 1, 0); PG8_STAGE(PG8_SA(0, 1), a2 + hstep, voffA);
            PG8_WAIT_V(8); PG8_WAIT_L(0); PG8_BAR; PG8_MMA(0, 0, At, B0); PG8_MMA(0, 1, At, B1); PG8_BAR; PG8_SCHED;
            PG8_LDA(At, 1, 1); PG8_STAGE(PG8_SB(1, 0), b3, voffB); PG8_STAGE(PG8_SB(1, 1), b3 + hstep, voffB); PG8_STAGE(PG8_SA(1, 0), a3, voffA);
            PG8_WAIT_V(8); PG8_WAIT_L(0); PG8_BAR; PG8_MMA(1, 0, At, B0); PG8_MMA(1, 1, At, B1); PG8_BAR; PG8_SCHED;
            } else {
            PG8_LDB(B0, 0, 0); PG8_SCHED; PG8_LDA(At, 0, 0); PG8_STAGE(PG8_SA(1, 1), a1 + hstep, voffA);
            PG8_WAIT_L(8); PG8_BAR; PG8_WAIT_L(0); PG8_MMA(0, 0, At, B0); PG8_BAR; PG8_SCHED;
            PG8_LDB(B1, 0, 1); PG8_STAGE(PG8_SB(0, 0), b2, voffB);
            PG8_BAR; PG8_WAIT_L(0); PG8_MMA(0, 1, At, B1); PG8_BAR;
            PG8_LDA(At, 0, 1); PG8_STAGE(PG8_SA(0, 0), a2, voffA);
            PG8_BAR; PG8_WAIT_L(0); PG8_MMA(1, 0, At, B0); PG8_BAR; PG8_SCHED;
            PG8_STAGE(PG8_SB(0, 1), b2 + hstep, voffB);
            PG8_WAIT_V(6); PG8_BAR; PG8_MMA(1, 1, At, B1); PG8_BAR;
            PG8_LDB(B0, 1, 0); PG8_SCHED; PG8_LDA(At, 1, 0); PG8_STAGE(PG8_SA(0, 1), a2 + hstep, voffA);
            PG8_WAIT_L(8); PG8_BAR; PG8_WAIT_L(0); PG8_MMA(0, 0, At, B0); PG8_BAR; PG8_SCHED;
            PG8_LDB(B1, 1, 1); PG8_STAGE(PG8_SB(1, 0), b3, voffB);
            PG8_BAR; PG8_WAIT_L(0); PG8_MMA(0, 1, At, B1); PG8_BAR;
            PG8_LDA(At, 1, 1); PG8_STAGE(PG8_SA(1, 0), a3, voffA);
            PG8_BAR; PG8_WAIT_L(0); PG8_MMA(1, 0, At, B0); PG8_BAR; PG8_SCHED;
            PG8_STAGE(PG8_SB(1, 1), b3 + hstep, voffB);
            PG8_WAIT_V(6); PG8_BAR; PG8_MMA(1, 1, At, B1); PG8_BAR;
            }
        }
        if constexpr (ALIGN_EPI) { if (wr == 0) PG8_BAR; }
        E(acc, cur, ui, wr, wc, fr, fq);
        if (!has_next) break;
#pragma unroll
        for (int a = 0; a < 2; ++a)
#pragma unroll
            for (int b = 0; b < 2; ++b)
#pragma unroll
                for (int m = 0; m < 4; ++m)
#pragma unroll
                    for (int n = 0; n < 2; ++n) acc[a][b][m][n] = (f32x4){0.f, 0.f, 0.f, 0.f};
        cur = nxt; cA = nA; cB = nB; ++ui;
        if constexpr (ALIGN_EPI) { if (wr == 1) PG8_BAR; }
    }
    PG8_WAIT_V(0);
    if constexpr (!ALIGN_EPI) { if (wr == 0) PG8_BAR; }
    PG8_BAR;
#undef PG8_SA
#undef PG8_SB
#undef PG8_STAGE
#undef PG8_LDA
#undef PG8_LDB
#undef PG8_MMA
#undef PG8_WAIT_V
#undef PG8_WAIT_L
#undef PG8_BAR
#undef PG8_SCHED
}
}

constexpr int NWAVES = 8, NTHR = 512;
constexpr int LDS_BYTES = 131072 + 256 + 16 * 1024;
#define LDS_WAIT() asm volatile("s_waitcnt lgkmcnt(0)" ::: "memory")

__device__ __forceinline__ void tr_item(const float* W, int K, int N, bf16_t* WT, const float* gain, int mode, LAS float* scr, int item, int lane) {
    const int nblk = N / 32, kb = item / nblk, nb = item % nblk, k0 = 64 * kb, n0 = 32 * nb;
    int ns = n0;
    if (mode) { const int t = n0 >> 8, j = n0 & 255;
        if (t < 4) ns = (j < 128) ? 128 * t + j : 512 + 128 * t + (j - 128);
        else if (t < 8) ns = (j < 128) ? 1536 + 128 * (t - 4) + j : 2048 + 128 * (t - 4) + (j - 128);
        else ns = 1024 + 256 * (t - 8) + j; }
#pragma unroll
    for (int i = 0; i < 32; ++i) { const int kk = 2 * i + (lane >> 5); const float gk = gain ? gain[k0 + kk] : 1.0f; scr[kk * 33 + (lane & 31)] = __builtin_nontemporal_load(W + (size_t)(k0 + kk) * N + ns + (lane & 31)) * gk; }
    LDS_WAIT(); asm volatile("" ::: "memory");
    const int c = lane & 7;
#pragma unroll
    for (int j = 0; j < 4; ++j) { const int n = (lane >> 3) + 8 * j; const LAS float* s = scr + (8 * c) * 33 + n;
        u32x4 o; o.x = cvt_pk_bf16(s[0 * 33], s[1 * 33]); o.y = cvt_pk_bf16(s[2 * 33], s[3 * 33]); o.z = cvt_pk_bf16(s[4 * 33], s[5 * 33]); o.w = cvt_pk_bf16(s[6 * 33], s[7 * 33]);
        *(u32x4*)(WT + (size_t)(n0 + n) * K + k0 + 8 * c) = o; }
    LDS_WAIT(); asm volatile("" ::: "memory");
}

struct Params { const float* in[21]; float* out; unsigned char* ws; };

constexpr int CR = 16;
template <int J, int I> __device__ __forceinline__ void conv_tap(f32x2 (&acc)[CR], const f32x2 (&w)[31], f32x2 x) {
    if constexpr (J - I >= 0 && J - I <= 30) acc[I] += w[J - I] * x;
}
template <int J, int... I> __device__ __forceinline__ void conv_row(f32x2 (&acc)[CR], const f32x2 (&w)[31], f32x2 x, std::integer_sequence<int, I...>) { (conv_tap<J, I>(acc, w, x), ...); }
template <int J> __device__ __forceinline__ void conv_j(f32x2 (&acc)[CR], const f32x2 (&w)[31], const unsigned (&xw)[CR + 30]) {
    const unsigned xv = xw[J];
    conv_row<J>(acc, w, (f32x2){bf_lo(xv), bf_hi(xv)}, std::make_integer_sequence<int, CR>{});
}
template <int... J> __device__ __forceinline__ void conv_all(f32x2 (&acc)[CR], const f32x2 (&w)[31], const unsigned (&xw)[CR + 30], std::integer_sequence<int, J...>) { (conv_j<J>(acc, w, xw), ...); }
template <int OFF, int... J> __device__ __forceinline__ void conv_load(unsigned (&xw)[CR + 30], const bf16_t* src, int tl, std::integer_sequence<int, J...>) {
    ((xw[OFF + J] = (tl - 30 + OFF + J >= 0) ? *(const unsigned*)(src + (size_t)(OFF + J) * NG1) : 0u), ...);
}
constexpr int CV_EARLY = 24;
__device__ __forceinline__ float xreduce16(const float (&v)[16], int lane) {
    float b[8], c[4], d[2], e;
    { const bool up = lane & 32;
#pragma unroll
      for (int i = 0; i < 8; ++i) { const float keep = up ? v[i + 8] : v[i], send = up ? v[i] : v[i + 8]; b[i] = keep + __shfl_xor(send, 32); } }
    { const bool up = lane & 16;
#pragma unroll
      for (int i = 0; i < 4; ++i) { const float keep = up ? b[i + 4] : b[i], send = up ? b[i] : b[i + 4]; c[i] = keep + __shfl_xor(send, 16); } }
    { const bool up = lane & 8;
#pragma unroll
      for (int i = 0; i < 2; ++i) { const float keep = up ? c[i + 2] : c[i], send = up ? c[i] : c[i + 2]; d[i] = keep + __shfl_xor(send, 8); } }
    { const bool up = lane & 4; const float keep = up ? d[1] : d[0], send = up ? d[0] : d[1]; e = keep + __shfl_xor(send, 4); }
    e += __shfl_xor(e, 2); e += __shfl_xor(e, 1);
    return e;
}

__device__ __forceinline__ void conv_phase(const Params& P, const bf16_t* G1, bf16_t* MX, LAS unsigned char* lds, int NGRP, int xg, int xr, int XR) {
    const float* caw = P.in[3]; const float* cab = P.in[4]; const float* lng = P.in[5]; const float* lnb = P.in[6]; const float* cbw = P.in[7];
    int tid_ = threadIdx.x; asm volatile("" : "+v"(tid_));
    const int tid = tid_, grp = tid >> 8, t8 = tid & 255, lane = tid & 63, wv = (tid >> 6) & 3;
    const int c0 = 2 * t8;
    LAS float* red = (LAS float*)lds;
    LAS float* st = (LAS float*)(lds + 4096);
    f32x2 w[31];
#pragma unroll
    for (int k = 0; k < 31; ++k) w[k] = *(const f32x2*)(caw + k * 512 + c0);
    const f32x2 cb = *(const f32x2*)(cab + c0), lg = *(const f32x2*)(lng + c0), lb = *(const f32x2*)(lnb + c0);
    const f32x2 wb0 = *(const f32x2*)(cbw + c0), wb1 = *(const f32x2*)(cbw + 512 + c0), wb2 = *(const f32x2*)(cbw + 1024 + c0);
    const int per_grp = (M / 32) / NGRP, nit = (per_grp - xr + XR - 1) / XR;
#define CV_BAR() do { asm volatile("s_waitcnt lgkmcnt(0)" ::: "memory"); __builtin_amdgcn_s_barrier(); asm volatile("" ::: "memory"); } while (0)
#define CV_T0(k_) ((xg * per_grp + xr + (k_) * XR) * 32 + grp * CR)
#define CV_LOAD(XW, k_) do { const int t0_ = CV_T0(k_); conv_load<0>(XW, G1 + (size_t)(t0_ - 30) * NG1 + c0, t0_ & (SEQ - 1), std::make_integer_sequence<int, CV_EARLY>{}); } while (0)
#define CV_BODY(XW, k_) do { const int t0 = CV_T0(k_), tl = t0 & (SEQ - 1); \
        conv_load<CV_EARLY>(XW, G1 + (size_t)(t0 - 30) * NG1 + c0, tl, std::make_integer_sequence<int, CR + 30 - CV_EARLY>{}); \
        f32x2 acc[CR]; \
        _Pragma("unroll") for (int i = 0; i < CR; ++i) acc[i] = cb; \
        conv_all(acc, w, XW, std::make_integer_sequence<int, CR + 30>{}); \
        const bf16_t* ps = G1 + (size_t)t0 * NG1 + 512 + c0; const bf16_t* bg = G1 + (size_t)t0 * NG1 + 1024 + c0; \
        unsigned pa = 0u, pb = 0u; if (tl != 0) { pa = *(const unsigned*)(ps - 2 * (size_t)NG1); pb = *(const unsigned*)(ps - (size_t)NG1); } \
        float S, Q; \
        { float sv[CR]; _Pragma("unroll") for (int i = 0; i < CR; ++i) sv[i] = acc[i].x + acc[i].y; S = xreduce16(sv, lane); } \
        { float qv[CR]; _Pragma("unroll") for (int i = 0; i < CR; ++i) qv[i] = acc[i].x * acc[i].x + acc[i].y * acc[i].y; Q = xreduce16(qv, lane); } \
        if ((lane & 3) == 0) *(LAS f32x2*)(red + ((grp * 4 + wv) * CR + (lane >> 2)) * 2) = (f32x2){S, Q}; \
        CV_BAR(); \
        if (t8 < CR) { float s_ = 0.f, q_ = 0.f; \
            _Pragma("unroll") for (int x = 0; x < 4; ++x) { const f32x2 t = *(const LAS f32x2*)(red + ((grp * 4 + x) * CR + t8) * 2); s_ += t.x; q_ += t.y; } \
            const float mean = s_ * (1.0f / 512.0f), var = q_ * (1.0f / 512.0f) - mean * mean; \
            *(LAS f32x2*)(st + (grp * CR + t8) * 2) = (f32x2){mean, __builtin_amdgcn_rsqf(var + LN_EPS)}; } \
        CV_BAR(); \
        bf16_t* dst = MX + (size_t)t0 * D + c0; \
        _Pragma("unroll") for (int i = 0; i < CR; ++i) { const f32x2 ms = *(const LAS f32x2*)(st + (grp * CR + i) * 2); \
            const float y0 = (acc[i].x - ms.x) * ms.y * lg.x + lb.x, y1 = (acc[i].y - ms.x) * ms.y * lg.y + lb.y; \
            *(unsigned*)(dst + (size_t)i * D) = cvt_pk_bf16(y0 * fast_sigmoid(y0), y1 * fast_sigmoid(y1)); } \
          \
        float p2x = bf_lo(pa), p2y = bf_hi(pa), p1x = bf_lo(pb), p1y = bf_hi(pb); \
        _Pragma("unroll") for (int i = 0; i < CR; ++i) { const unsigned pvi = __builtin_nontemporal_load((const unsigned*)(ps + (size_t)i * NG1)), gvi = __builtin_nontemporal_load((const unsigned*)(bg + (size_t)i * NG1)); const float px = bf_lo(pvi), py = bf_hi(pvi); \
            const float ox = bf_lo(gvi) * (wb0.x * p2x + wb1.x * p1x + wb2.x * px), oy = bf_hi(gvi) * (wb0.y * p2y + wb1.y * p1y + wb2.y * py); \
            *(unsigned*)(dst + (size_t)i * D + 512) = cvt_pk_bf16(ox, oy); \
            p2x = p1x; p2y = p1y; p1x = px; p1y = py; } } while (0)
    unsigned xa[CR + 30], xb[CR + 30];
    if (nit > 0) CV_LOAD(xa, 0);
    for (int k = 0; k < nit; k += 2) {
        const bool has1 = k + 1 < nit, has2 = k + 2 < nit;
        if (has1) CV_LOAD(xb, k + 1);
        CV_BODY(xa, k);
        if (has1) { if (has2) CV_LOAD(xa, k + 2); CV_BODY(xb, k + 1); }
    }
#undef CV_BAR
#undef CV_T0
#undef CV_LOAD
#undef CV_BODY
}

constexpr int SG_STRIDE = 272, SG_TILE = 128 * SG_STRIDE, SG_STAT = 0, SG_GAIN = 16384, SG_TILES = 24576;
__device__ __forceinline__ void sgu_phase(const Params& P, const bf16_t* U, const bf16_t* V, bf16_t* Y, LAS unsigned char* lds, int NGRP, int xg, int xr, int XR) {
    const f32x2* VST = (const f32x2*)(P.ws + WS_VST); const bf16_t* WSB = (const bf16_t*)(P.ws + WS_WSB);
    const float* lvg = P.in[12]; const float* lvb = P.in[13]; const float* bs = P.in[15];
    int tid_ = threadIdx.x; asm volatile("" : "+v"(tid_));
    const int tid = tid_, wid = __builtin_amdgcn_readfirstlane(tid >> 6), lane = tid & 63, fr = lane & 15, fq = lane >> 4;
    const int wt = wid >> 1, wcn = wid & 1;
    LAS float* stat = (LAS float*)(lds + SG_STAT);
    LAS float* gain = (LAS float*)(lds + SG_GAIN);
    LAS unsigned char* tiles = lds + SG_TILES;
    const int lr = tid >> 4, lc = tid & 15;
    const int trb = ((lane & 15) >> 2) * SG_STRIDE + (lane & 3) * 8 + fq * 8 * SG_STRIDE + wcn * 128;
    const int per_grp = (M / 128) / NGRP, vblk = xg * per_grp + xr, G = XR;
    int nch = (per_grp - xr + XR - 1) / XR; if (nch > 16) nch = 16;
    const int NIT = nch * 8;
    for (int i = tid; i < nch * 128; i += NTHR) { const int row = (vblk + G * (i >> 7)) * 128 + (i & 127);
        const f32x4* p = (const f32x4*)(VST + (size_t)row * 16); float sm = 0.f, q = 0.f;
#pragma unroll
        for (int x = 0; x < 8; ++x) { const f32x4 t = p[x]; sm += t.x + t.z; q += t.y + t.w; }
        const float mean = sm * (1.0f / 1024.0f), var = q * (1.0f / 1024.0f) - mean * mean;
        *(LAS f32x2*)(stat + i * 2) = (f32x2){mean, __builtin_amdgcn_rsqf(var + LN_EPS)}; }
    for (int i = tid; i < 1024; i += NTHR) { gain[i] = lvg[i]; gain[1024 + i] = lvb[i]; }
    u32x4 vr[4]; bf16x8 af[2][4]; u32x2 ur[2][4]; float bsv[2];
#define SG_LOAD(n_, VR, AF, UR, BSV, LDA_) do { const int g_ = (n_) / nch, row0_ = (vblk + G * ((n_) - g_ * nch)) * 128; \
        _Pragma("unroll") for (int i = 0; i < 4; ++i) VR[i] = __builtin_nontemporal_load((const u32x4*)(V + (size_t)(row0_ + lr + 32 * i) * D + g_ * 128 + lc * 8)); \
        const bf16_t* wsg_ = WSB + (size_t)(g_ * 128 + 32 * wt + fr) * 128 + 8 * fq; \
        if (LDA_) { _Pragma("unroll") for (int mb = 0; mb < 2; ++mb) { _Pragma("unroll") for (int kk = 0; kk < 4; ++kk) AF[mb][kk] = *(const bf16x8*)(wsg_ + (size_t)(16 * mb) * 128 + 32 * kk); } } \
        _Pragma("unroll") for (int mb = 0; mb < 2; ++mb) { \
            const int tloc_ = 32 * wt + 16 * mb + fr; const size_t ro_ = (size_t)(row0_ + tloc_) * D + g_ * 128 + 64 * wcn + 4 * fq; BSV[mb] = bs[g_ * 128 + tloc_]; \
            _Pragma("unroll") for (int nb = 0; nb < 4; ++nb) UR[mb][nb] = __builtin_nontemporal_load((const u32x2*)(U + ro_ + 16 * nb)); } } while (0)
    SG_LOAD(0, vr, af, ur, bsv, true);
    __syncthreads();
    for (int n = 0; n < NIT; ++n) {
        const int g = n / nch, ci = n - g * nch, row0 = (vblk + G * ci) * 128;
        LAS unsigned char* tile = tiles + (n & 1) * SG_TILE;
        { const f32x4 g0 = *(const LAS f32x4*)(gain + g * 128 + lc * 8), g1 = *(const LAS f32x4*)(gain + g * 128 + lc * 8 + 4);
          const f32x4 b0 = *(const LAS f32x4*)(gain + 1024 + g * 128 + lc * 8), b1 = *(const LAS f32x4*)(gain + 1024 + g * 128 + lc * 8 + 4);
#pragma unroll
          for (int i = 0; i < 4; ++i) { const int rr = lr + 32 * i; const f32x2 ms = *(const LAS f32x2*)(stat + (ci * 128 + rr) * 2);
            const u32x4 raw = vr[i]; const float mu = ms.x, rs = ms.y;
            u32x4 o;
            o.x = cvt_pk_bf16((bf_lo(raw.x) - mu) * rs * g0[0] + b0[0], (bf_hi(raw.x) - mu) * rs * g0[1] + b0[1]);
            o.y = cvt_pk_bf16((bf_lo(raw.y) - mu) * rs * g0[2] + b0[2], (bf_hi(raw.y) - mu) * rs * g0[3] + b0[3]);
            o.z = cvt_pk_bf16((bf_lo(raw.z) - mu) * rs * g1[0] + b1[0], (bf_hi(raw.z) - mu) * rs * g1[1] + b1[1]);
            o.w = cvt_pk_bf16((bf_lo(raw.w) - mu) * rs * g1[2] + b1[2], (bf_hi(raw.w) - mu) * rs * g1[3] + b1[3]);
            *(LAS u32x4*)(tile + rr * SG_STRIDE + lc * 16) = o; } }
        __syncthreads();
        u32x4 vrn[4]; bf16x8 afn[2][4]; u32x2 urn[2][4]; float bsn[2];
        { const int nn = (n + 1 < NIT) ? n + 1 : n; const bool newg = (nn / nch) != g;
#pragma unroll
          for (int mb = 0; mb < 2; ++mb)
#pragma unroll
              for (int k = 0; k < 4; ++k) afn[mb][k] = af[mb][k];
          SG_LOAD(nn, vrn, afn, urn, bsn, newg); }
        f32x4 acc[2][4];
#pragma unroll
        for (int mb = 0; mb < 2; ++mb)
#pragma unroll
            for (int nb = 0; nb < 4; ++nb) acc[mb][nb] = (f32x4){0.f, 0.f, 0.f, 0.f};
#pragma unroll
        for (int kk = 0; kk < 4; ++kk) {
#pragma unroll
            for (int nb = 0; nb < 4; ++nb) {
                const LAS unsigned char* tp = tile + trb + kk * 32 * SG_STRIDE + nb * 32;
                const s16x4 lo = __builtin_amdgcn_ds_read_tr16_b64_v4i16((LAS s16x4*)(tp));
                const s16x4 hi = __builtin_amdgcn_ds_read_tr16_b64_v4i16((LAS s16x4*)(tp + 4 * SG_STRIDE));
                const bf16x8 bf = __builtin_shufflevector(lo, hi, 0, 1, 2, 3, 4, 5, 6, 7);
#pragma unroll
                for (int mb = 0; mb < 2; ++mb) acc[mb][nb] = __builtin_amdgcn_mfma_f32_16x16x32_bf16(bf, af[mb][kk], acc[mb][nb], 0, 0, 0);
            }
        }
#pragma unroll
        for (int mb = 0; mb < 2; ++mb) { const int tloc = 32 * wt + 16 * mb + fr;
            const size_t ro = (size_t)(row0 + tloc) * D + g * 128 + 64 * wcn + 4 * fq;
#pragma unroll
            for (int nb = 0; nb < 4; ++nb) { const u32x2 uv = ur[mb][nb]; const f32x4 a = acc[mb][nb]; const float bb = bsv[mb];
                u32x2 o; o.x = cvt_pk_bf16(bf_lo(uv.x) * (a[0] + bb), bf_hi(uv.x) * (a[1] + bb)); o.y = cvt_pk_bf16(bf_lo(uv.y) * (a[2] + bb), bf_hi(uv.y) * (a[3] + bb));
                *(u32x2*)(Y + ro + 16 * nb) = o; } }
#pragma unroll
        for (int i = 0; i < 4; ++i) vr[i] = vrn[i];
#pragma unroll
        for (int mb = 0; mb < 2; ++mb) { bsv[mb] = bsn[mb];
#pragma unroll
            for (int k = 0; k < 4; ++k) { af[mb][k] = afn[mb][k]; ur[mb][k] = urn[mb][k]; } }
    }
#undef SG_LOAD
}

#define XB_TMO      128
#define XB_XCNT(j)  (256  + 64 * (j))
#define XB_XSUB(j)  (1280 + 64 * (j))
#define XB_XGEN(j)  (2304 + 64 * (j))
#define XB_TOP      3328
#define XB_TOPGEN   3392
#define XB_LSUB(j)  (3456 + 64 * (j))
#define XB_PCNT(pm) (4480 + 16 * (pm))
#define XCD_BAR_WORDS (4480 + 16 * 128)
#define XB_SPIN_CAP (1u << 18)
__device__ __forceinline__ unsigned xb_ld(unsigned* p)              { return __hip_atomic_load(p, __ATOMIC_RELAXED, __HIP_MEMORY_SCOPE_AGENT); }
__device__ __forceinline__ unsigned xb_add(unsigned* p, unsigned v) { return __hip_atomic_fetch_add(p, v, __ATOMIC_RELAXED, __HIP_MEMORY_SCOPE_AGENT); }
__device__ __forceinline__ unsigned xb_xcc_id() { return (unsigned)__builtin_amdgcn_s_getreg((3 << 11) | 20) & 0xFu; }
#define XB_SPIN(cond, bar) do { unsigned _sp = 0; while (cond) { __builtin_amdgcn_s_sleep(1); \
    if ((++_sp & 255u) == 0u) { if (xb_ld(&(bar)[XB_TMO])) break; if (_sp > XB_SPIN_CAP) { atomicAdd(&(bar)[XB_TMO], 1u); break; } } } } while (0)
struct XcdBarrier { unsigned* bar; unsigned x; volatile LAS unsigned* st; };
__device__ __forceinline__ XcdBarrier xcd_barrier_post(unsigned* bar, volatile LAS unsigned* st) {
    XcdBarrier b; b.bar = bar; b.x = xb_xcc_id(); b.st = st;
    if (threadIdx.x == 0) st[2] = xb_add(&bar[XB_XCNT(b.x)], 1u);
    return b;
}
__device__ __forceinline__ void xcd_barrier_complete(unsigned* bar, unsigned x, unsigned& nloc, unsigned& nx) {
    const unsigned G = gridDim.x * gridDim.y * gridDim.z;
    unsigned sum, cnt, mine, sp = 0u;
    for (;;) {
        sum = 0u; cnt = 0u; mine = 0u;
#pragma unroll
        for (unsigned j = 0; j < 16; ++j) { const unsigned c = xb_ld(&bar[XB_XCNT(j)]); sum += c; cnt += (c > 0u) ? 1u : 0u; mine = (j == x) ? c : mine; }
        if (sum == G) break;
        __builtin_amdgcn_s_sleep(1);
        if ((++sp & 255u) == 0u) { if (xb_ld(&bar[XB_TMO])) break; if (sp > XB_SPIN_CAP) { atomicAdd(&bar[XB_TMO], 1u); break; } }
    }
    nloc = mine > 0u ? mine : 1u; nx = cnt > 0u ? cnt : 1u;
}
__device__ __forceinline__ void xcd_barrier(const XcdBarrier& b) {
    asm volatile("s_waitcnt vmcnt(0)" ::: "memory");
    __syncthreads();
    if (threadIdx.x == 0) {
        unsigned* bar = b.bar;
        __builtin_amdgcn_s_waitcnt(0);
        unsigned nloc = b.st[0], nx = b.st[1];
        if (nloc == 0u) { xcd_barrier_complete(bar, b.x, nloc, nx); b.st[0] = nloc; b.st[1] = nx; }
        const unsigned old = xb_add(&bar[XB_XSUB(b.x)], 1u);
        const unsigned gen = old / nloc;
        if (old + 1u == (gen + 1u) * nloc) {
            __builtin_amdgcn_fence(__ATOMIC_RELEASE, "agent");
            asm volatile("s_waitcnt vmcnt(0)" ::: "memory");
            const unsigned og = xb_add(&bar[XB_TOP], 1u);
            const unsigned tg = og / nx;
            if (og + 1u == (tg + 1u) * nx) xb_add(&bar[XB_TOPGEN], 1u);
            else XB_SPIN(xb_ld(&bar[XB_TOPGEN]) == tg, bar);
            __builtin_amdgcn_fence(__ATOMIC_ACQUIRE, "agent");
            xb_add(&bar[XB_XGEN(b.x)], 1u);
            asm volatile("s_waitcnt vmcnt(0)" ::: "memory");
        } else {
            XB_SPIN(xb_ld(&bar[XB_XGEN(b.x)]) == gen, bar);
            __builtin_amdgcn_fence(__ATOMIC_ACQUIRE, "agent");
            asm volatile("s_waitcnt vmcnt(0)" ::: "memory");
        }
    }
    __syncthreads();
}

__device__ __forceinline__ void xcd_local_barrier(const XcdBarrier& b, unsigned nloc) {
    asm volatile("s_waitcnt vmcnt(0)" ::: "memory");
    __syncthreads();
    if (threadIdx.x == 0) {
        unsigned* bar = b.bar;
        __builtin_amdgcn_s_waitcnt(0);
        const unsigned old = xb_add(&bar[XB_LSUB(b.x)], 1u);
        const unsigned target = (old / nloc + 1u) * nloc;
        XB_SPIN(xb_ld(&bar[XB_LSUB(b.x)]) < target, bar);
        __builtin_amdgcn_fence(__ATOMIC_ACQUIRE, "agent");
        asm volatile("s_waitcnt vmcnt(0)" ::: "memory");
    }
    __syncthreads();
}
__device__ __forceinline__ void xcd_classify(const XcdBarrier& b) {
    if (threadIdx.x == 0) {
        const unsigned G = gridDim.x; unsigned cnt = 0u, dense = 0u; bool uni = (G % 8u) == 0u;
#pragma unroll
        for (unsigned j = 0; j < 16; ++j) { const unsigned c = xb_ld(&b.bar[XB_XCNT(j)]); if (c > 0u) { ++cnt; if (c != G / 8u) uni = false; if (j < b.x) ++dense; } }
        b.st[3] = (uni && cnt == 8u) ? 1u : 0u; b.st[4] = dense;
    }
    __syncthreads();
}
__global__ void __launch_bounds__(NTHR, 2) fwd_megakernel(Params P) {
    extern __shared__ __attribute__((aligned(16))) unsigned char lds_raw[];
    LAS unsigned char* lds = (LAS unsigned char*)lds_raw;
    cg::grid_group grid = cg::this_grid();
    const int tid = threadIdx.x, lane = tid & 63, wave = __builtin_amdgcn_readfirstlane(tid >> 6);
    const int G = gridDim.x, bx = blockIdx.x;
    const int vblk = (G % 8 == 0) ? (bx % 8) * (G / 8) + bx / 8 : bx;
    const int NGRP0 = (G % 8 == 0) ? 8 : 1, xg0 = bx % NGRP0, xr0 = bx / NGRP0, XR0 = G / NGRP0;
    unsigned char* ws = P.ws;
    volatile LAS unsigned* misc = (volatile LAS unsigned*)(lds + 131072);
    if (tid < 16) misc[tid] = 0u;
    __syncthreads();
    const XcdBarrier xbar = xcd_barrier_post((unsigned*)(ws + WS_BAR), misc);
    bf16_t* XB = (bf16_t*)(ws + WS_XB);
    float* SS0 = (float*)(ws + WS_SS); float* SS1 = SS0 + (size_t)M * 16; float* SS2 = SS1 + (size_t)M * 16; float* SS3 = SS2 + (size_t)M * 16; float* SS4 = SS3 + (size_t)M * 16;
    bf16_t* WIN0 = (bf16_t*)(ws + WS_WIN0); bf16_t* WOUT0 = (bf16_t*)(ws + WS_WOUT0); bf16_t* W1_0 = (bf16_t*)(ws + WS_W1_0); bf16_t* W2_0 = (bf16_t*)(ws + WS_W2_0);
    bf16_t* WIN1 = (bf16_t*)(ws + WS_WIN1); bf16_t* WOUT1 = (bf16_t*)(ws + WS_WOUT1); bf16_t* W1_1 = (bf16_t*)(ws + WS_W1_1); bf16_t* W2_1 = (bf16_t*)(ws + WS_W2_1);

    {
        LAS float* scr = (LAS float*)(lds + wave * 16384);
        const int gw = vblk * NWAVES + wave, NGW = G * NWAVES;
        constexpr int I0 = 16 * 80, I1 = 16 * 32, I2 = 16 * 128, I3 = 64 * 32, I4 = 16 * 64, I5 = 16 * 32, I6 = 16 * 128, I7 = 64 * 32;
        constexpr int NITEMS = I0 + I1 + I2 + I3 + I4 + I5 + I6 + I7;
        for (int it = gw; it < NITEMS; it += NGW) {
            int r = it;
            if (r < I0) { tr_item(P.in[2], D, NIN0, WIN0, P.in[1], 1, scr, r, lane); continue; } r -= I0;
            if (r < I1) { tr_item(P.in[8], D, D, WOUT0, nullptr, 0, scr, r, lane); continue; } r -= I1;
            if (r < I2) { tr_item(P.in[18], D, FF, W1_0, P.in[17], 0, scr, r, lane); continue; } r -= I2;
            if (r < I3) { tr_item(P.in[19], FF, D, W2_0, nullptr, 0, scr, r, lane); continue; } r -= I3;
            if (r < I4) { tr_item(P.in[10], D, NIN1, WIN1, P.in[9], 0, scr, r, lane); continue; } r -= I4;
            if (r < I5) { tr_item(P.in[16], D, D, WOUT1, nullptr, 0, scr, r, lane); continue; } r -= I5;
            if (r < I6) { tr_item(P.in[18] + (size_t)D * FF, D, FF, W1_1, P.in[17] + D, 0, scr, r, lane); continue; } r -= I6;
            tr_item(P.in[19] + (size_t)FF * D, FF, D, W2_1, nullptr, 0, scr, r, lane);
        }
        { bf16_t* WSB = (bf16_t*)(ws + WS_WSB); const float* wsrc = P.in[14];
          for (int i = vblk * NTHR + tid; i < 8 * 128 * 128 / 2; i += G * NTHR) { const int e = 2 * i, s = e & 127, t = (e >> 7) & 127; const f32x2 v = *(const f32x2*)(wsrc + e);
              ((unsigned*)WSB)[i] = cvt_pk_bf16(s <= t ? v.x : 0.f, (s + 1) <= t ? v.y : 0.f); } }
        const float* x = P.in[0];
        const int RPG = M / NGRP0, rbase = xg0 * RPG, lw = xr0 * NWAVES + wave, LW = XR0 * NWAVES;
        for (int r0 = lw; r0 < RPG; r0 += 4 * LW) {
            f32x4 v[4][4];
#pragma unroll
            for (int u = 0; u < 4; ++u) { const int row = rbase + ((r0 + u * LW < RPG) ? r0 + u * LW : r0); const f32x4* xr = (const f32x4*)(x + (size_t)row * D) + lane;
#pragma unroll
                for (int j = 0; j < 4; ++j) v[u][j] = __builtin_nontemporal_load(xr + 64 * j); }
#pragma unroll
            for (int u = 0; u < 4; ++u) { const int row = rbase + r0 + u * LW; if (r0 + u * LW < RPG) { float s = 0.f;
#pragma unroll
                for (int j = 0; j < 4; ++j) { const f32x4 t = v[u][j]; s += (t.x * t.x + t.y * t.y) + (t.z * t.z + t.w * t.w);
                    u32x2 o; o.x = cvt_pk_bf16(t.x, t.y); o.y = cvt_pk_bf16(t.z, t.w); *(u32x2*)(XB + (size_t)row * D + 4 * lane + 256 * j) = o; }
                s += __shfl_xor(s, 1); s += __shfl_xor(s, 2);
                if ((lane & 3) == 0) SS0[(size_t)row * 16 + (lane >> 2)] = s; } }
        }
    }
    if (P.ws == nullptr) grid.sync();
    xcd_barrier(xbar);
    xcd_classify(xbar);
    const bool fast = misc[3] != 0u; const unsigned nloc = misc[0];
    const int NGRP = 8, xg = fast ? (int)misc[4] : bx % NGRP, xr = fast ? (int)misc[2] : bx / NGRP, XR = G / NGRP;
    const int cg_ = fast ? xr * 8 + xg : bx;
    bf16_t* const G1w = (bf16_t*)(ws + WS_R + (size_t)xg * (20 * MiB)); bf16_t* const Uw = (bf16_t*)(ws + WS_R + (size_t)xg * (24 * MiB));
    bf16_t* const Vw = (bf16_t*)(ws + WS_R + 8 * MiB + (size_t)xg * (24 * MiB)); bf16_t* const MXw = (bf16_t*)(ws + WS_R + 16 * MiB + (size_t)xg * (24 * MiB));
#define SEAM() do { if (fast) xcd_local_barrier(xbar, nloc); else xcd_barrier(xbar); } while (0)
    const LAS float* const rs_tab = (const LAS float*)(lds + pg8::STAGE_BYTES + 256);
    { pg8::Gemm g{XB, WIN0, M, NIN0, D}; pg8::StaticOrder S; S.init(M, NIN0, G, cg_); pg8::EpiInEven E{G1w, SS0, rs_tab};
      pg8::gemm_phase<pg8::EpiInEven, pg8::StaticOrder, true, true>(lds, g, S, E); }
    SEAM();
    conv_phase(P, G1w, MXw, lds, NGRP, xg, xr, XR);
    SEAM();
    { pg8::Gemm g{MXw, WOUT0, M, D, D}; pg8::StaticOrder S; S.init(M, D, G, cg_); pg8::EpiRes E{XB, XB, SS1};
      pg8::gemm_phase<pg8::EpiRes, pg8::StaticOrder, true, true>(lds, g, S, E); }
    SEAM();
    { pg8::Gemm g{XB, W1_0, M, FF, D}; pg8::StaticOrder S; S.init(M, FF, G, cg_); pg8::EpiHid E{(bf16_t*)(ws + WS_HID), SS1, rs_tab};
      pg8::gemm_phase<pg8::EpiHid, pg8::StaticOrder, true, true>(lds, g, S, E); }
    SEAM();
    { pg8::Gemm g{(const bf16_t*)(ws + WS_HID), W2_0, M, D, FF}; pg8::StaticOrder S; S.init(M, D, G, cg_);
      pg8::EpiRes E{XB, XB, SS2};
      pg8::gemm_phase<pg8::EpiRes, pg8::StaticOrder, true, true>(lds, g, S, E); }
    SEAM();
    { pg8::Gemm g{XB, WIN1, M, NIN1, D}; pg8::StaticOrder S; S.init(M, NIN1, G, cg_);
      pg8::EpiInOdd E{Uw, Vw, SS2, P.in[11], (f32x2*)(ws + WS_VST), rs_tab};
      pg8::gemm_phase<pg8::EpiInOdd, pg8::StaticOrder, true, true>(lds, g, S, E); }
    SEAM();
    sgu_phase(P, Uw, Vw, MXw, lds, NGRP, xg, xr, XR);
    SEAM();
    { pg8::Gemm g{MXw, WOUT1, M, D, D}; pg8::StaticOrder S; S.init(M, D, G, cg_);
      pg8::EpiRes E{XB, XB, SS3};
      pg8::gemm_phase<pg8::EpiRes, pg8::StaticOrder, true, true>(lds, g, S, E); }
    SEAM();
    { pg8::Gemm g{XB, W1_1, M, FF, D}; pg8::StaticOrder S; S.init(M, FF, G, cg_); pg8::EpiHid E{(bf16_t*)(ws + WS_HID), SS3, rs_tab};
      pg8::gemm_phase<pg8::EpiHid, pg8::StaticOrder, true, true>(lds, g, S, E); }
    SEAM();
    { pg8::Gemm g{(const bf16_t*)(ws + WS_HID), W2_1, M, D, FF}; pg8::StaticOrder S; S.init(M, D, G, cg_);
      unsigned* const bw = (unsigned*)(ws + WS_BAR);
      pg8::EpiResFinal E{XB, P.out, P.in[20], (unsigned*)(ws + 60 * MiB), bw + XB_PCNT(0), bw + XB_TMO, (LAS float*)(lds + pg8::STAGE_BYTES + 256)};
      pg8::gemm_phase<pg8::EpiResFinal, pg8::StaticOrder, true, true>(lds, g, S, E); }
}

extern "C" void kernel_launch(void* const* d_in, const int* in_sizes, int n_in, void* d_out, int out_size, void* d_ws, size_t ws_size, hipStream_t stream) {
    static int grid_blocks = 0;
    if (grid_blocks == 0) {
        if (n_in != 21 || in_sizes[0] != M * D || out_size != M * D || ws_size < WS_END) { fprintf(stderr, "kernel_launch: unexpected shapes (n_in %d in0 %d out %d ws %zu)\n", n_in, n_in > 0 ? in_sizes[0] : -1, out_size, ws_size); grid_blocks = -1; return; }
        int dev = 0, cus = 0, per_cu = 0;
        (void)hipGetDevice(&dev); (void)hipDeviceGetAttribute(&cus, hipDeviceAttributeMultiprocessorCount, dev);
        if (hipFuncSetAttribute((const void*)fwd_megakernel, hipFuncAttributeMaxDynamicSharedMemorySize, LDS_BYTES) != hipSuccess) { fprintf(stderr, "kernel_launch: hipFuncSetAttribute failed\n"); grid_blocks = -1; return; }
        if (hipOccupancyMaxActiveBlocksPerMultiprocessor(&per_cu, (const void*)fwd_megakernel, NTHR, LDS_BYTES) != hipSuccess || per_cu < 1) { fprintf(stderr, "kernel_launch: occupancy query says %d\n", per_cu); per_cu = 1; }
        (void)hipGetLastError();
        if (cus % 8 != 0 || cus < 128) { fprintf(stderr, "kernel_launch: needs a CU count that is a multiple of 8 and >= 128 (got %d)\n", cus); grid_blocks = -1; return; }
        grid_blocks = cus * 1;
    }
    if (grid_blocks < 0) return;
    if (hipMemsetAsync((char*)d_ws + WS_BAR, 0, XCD_BAR_WORDS * 4, stream) != hipSuccess) { fprintf(stderr, "kernel_launch: memset of the barrier words failed\n"); return; }
    Params p{};
    for (int i = 0; i < 21; ++i) p.in[i] = (const float*)d_in[i];
    p.out = (float*)d_out; p.ws = (unsigned char*)d_ws;
    void* args[] = {&p};
    hipError_t e = hipLaunchCooperativeKernel((const void*)fwd_megakernel, dim3(grid_blocks), dim3(NTHR), args, LDS_BYTES, stream);
    if (e != hipSuccess) fprintf(stderr, "cooperative launch failed: %s (grid %d)\n", hipGetErrorString(e), grid_blocks);
}
```

```cpp
#include <hip/hip_runtime.h>
#include <hip/hip_cooperative_groups.h>
#include <cstdio>
#include <utility>
namespace cg = cooperative_groups;

#define LAS __attribute__((address_space(3)))
typedef unsigned short bf16_t;
typedef short bf16x8 __attribute__((ext_vector_type(8)));
typedef short s16x4 __attribute__((ext_vector_type(4)));
typedef float f32x4 __attribute__((ext_vector_type(4)));
typedef float f32x2 __attribute__((ext_vector_type(2)));
typedef unsigned u32x4 __attribute__((ext_vector_type(4)));
typedef unsigned u32x2 __attribute__((ext_vector_type(2)));

constexpr int D = 1024, SEQ = 2048, M = 16 * 2048, FF = 4096, NIN0 = 2560, NG1 = 1536, NIN1 = 2048;
constexpr float RMS_EPS = 1e-6f, LN_EPS = 1e-5f;
constexpr size_t MiB = 1u << 20;
constexpr size_t WS_WIN0 = 0, WS_WOUT0 = 5 * MiB, WS_W1_0 = 7 * MiB, WS_W2_0 = 15 * MiB, WS_WIN1 = 23 * MiB, WS_WOUT1 = 27 * MiB, WS_W1_1 = 29 * MiB, WS_W2_1 = 37 * MiB, WS_WSB = 45 * MiB;
constexpr size_t WS_SS = 46 * MiB  , WS_VST = 56 * MiB  , WS_XB = 64 * MiB  ;
constexpr size_t WS_R = 128 * MiB  , WS_HID = WS_R, WS_END = 384 * MiB, WS_BAR = 62 * MiB;

__device__ __forceinline__ unsigned cvt_pk_bf16(float lo, float hi) { unsigned r; asm volatile("v_cvt_pk_bf16_f32 %0, %1, %2" : "=v"(r) : "v"(lo), "v"(hi)); return r; }
__device__ __forceinline__ float bf_lo(unsigned v) { return __builtin_bit_cast(float, v << 16); }
__device__ __forceinline__ float bf_hi(unsigned v) { return __builtin_bit_cast(float, v & 0xffff0000u); }
__device__ __forceinline__ float relu1(float x) { float r; asm("v_max_f32_e32 %0, 0, %1" : "=v"(r) : "v"(x)); return r; }
__device__ __forceinline__ float fast_sigmoid(float x) { return __builtin_amdgcn_rcpf(1.0f + __builtin_amdgcn_exp2f(x * -1.44269504089f)); }

namespace pg8 {
constexpr int BM = 256, BK = 64, HALF = 128, HTB = HALF * BK * 2, STAGE_BYTES = 8 * HTB, NXCD = 8, WGM = 8;
__host__ __device__ __forceinline__ int lds_byte(int r, int c) { const int st = (r >> 4) * 2 + (c >> 5), rr = r & 15, cc = c & 31, ob = rr * 64 + cc * 2; return st * 1024 + (ob ^ (((ob >> 9) & 1) << 5)); }
__host__ __device__ __forceinline__ void stage_rc(int b, int& R, int& C) { const int st = b / 1024, sb = b % 1024, swz = sb ^ (((sb >> 9) & 1) << 5); R = (st >> 1) * 16 + swz / 64; C = (st & 1) * 32 + (swz % 64) / 2; }
__host__ __device__ __forceinline__ int perm32(int rho) { const int n = rho >> 4, i = rho & 15; return 8 * (i >> 2) + 4 * n + (i & 3); }
struct Unit { int pm, pn; };
struct Gemm { const bf16_t* A; const bf16_t* Bt; int M, N, K; };
struct StaticOrder {
    int nM, nN, nwg, G, c;
    __device__ void init(int M_, int N_, int G_, int c_) { nM = M_ / BM; nN = N_ / BM; nwg = nM * nN; G = G_; c = c_; }
    __device__ bool next(int i, Unit& u) const {
        const long L = (long)i * G + c; if (L >= nwg) return false;
        int wgid = (int)L; { const int q = nwg / NXCD, r = nwg % NXCD, xcd = wgid % NXCD, off = wgid / NXCD; wgid = (xcd < r ? xcd * (q + 1) : r * (q + 1) + (xcd - r) * q) + off; }
        const int nig = WGM * nN, gid = wgid / nig, fm = gid * WGM, gsz = (nM - fm) < WGM ? (nM - fm) : WGM;
        u.pm = fm + ((wgid % nig) % gsz); u.pn = (wgid % nig) / gsz; return true;
    }
};
__device__ __forceinline__ f32x2 gelu_pk(f32x2 v) {
    const f32x2 av = __builtin_elementwise_abs(v), d = av * 0.2316418882f + 1.0f;
    f32x2 t; t.x = __builtin_amdgcn_rcpf(d.x); t.y = __builtin_amdgcn_rcpf(d.y);
    f32x2 q = t * 0.5307027145f + (-0.7265760135f); q = q * t + 0.7107068705f; q = q * t + (-0.142248368f); q = q * t + 0.127414796f; q = q * t;
    const f32x2 s = (v * v) * (-0.72134752044f);
    f32x2 e; e.x = __builtin_amdgcn_exp2f(s.x); e.y = __builtin_amdgcn_exp2f(s.y);
    const f32x2 m = v * (q * e), r = v - m;
    f32x2 o; o.x = v.x < 0.f ? m.x : r.x; o.y = v.y < 0.f ? m.y : r.y; return o;
}
__device__ __forceinline__ float row_rs(const float* ss, int row) {
    const f32x4* p = (const f32x4*)(ss + (size_t)row * 16); f32x4 a = p[0], b = p[1], c = p[2], d = p[3]; a = (a + b) + (c + d);
    return __builtin_amdgcn_rsqf(((a.x + a.y) + (a.z + a.w)) * (1.0f / 1024.0f) + RMS_EPS);
}

struct EpiInEven {
    static constexpr bool PERM = true, AFTER_DRAIN = false;
    static constexpr bool NEEDS_RS = true;
    bf16_t* G1; const float* ss; const LAS float* rs_tab;
    __device__ __forceinline__ void operator()(const f32x4 (&acc)[2][2][4][2], const Unit& u, int ui, int wr, int wc, int fr, int fq) const {
        const LAS float* rsp = rs_tab + ui * 256 + wr * 64 + fr; float rsv[2][4];
#pragma unroll
        for (int ai = 0; ai < 2; ++ai)
#pragma unroll
            for (int m = 0; m < 4; ++m) rsv[ai][m] = rsp[ai * HALF + m * 16];
        const int row0 = u.pm * BM + wr * 64 + fr;
#pragma unroll
        for (int ai = 0; ai < 2; ++ai)
#pragma unroll
            for (int m = 0; m < 4; ++m) {
                const int row = row0 + ai * HALF + m * 16; const float r = rsv[ai][m];
                bf16_t* rowp = G1 + (size_t)row * NG1 + wc * 32 + 8 * fq;
                if (u.pn < 4) {
                    f32x4 v0 = acc[ai][0][m][0] * r, v1 = acc[ai][0][m][1] * r, g0 = acc[ai][1][m][0] * r, g1 = acc[ai][1][m][1] * r;
#pragma unroll
                    for (int j = 0; j < 4; ++j) { v0[j] *= fast_sigmoid(g0[j]); v1[j] *= fast_sigmoid(g1[j]); }
                    u32x4 w; w.x = cvt_pk_bf16(v0[0], v0[1]); w.y = cvt_pk_bf16(v0[2], v0[3]); w.z = cvt_pk_bf16(v1[0], v1[1]); w.w = cvt_pk_bf16(v1[2], v1[3]);
                    *(u32x4*)(rowp + 128 * u.pn) = w;
                } else if (u.pn < 8) {
                    const float r2 = r * r; f32x4 v0 = acc[ai][0][m][0] * acc[ai][1][m][0] * r2, v1 = acc[ai][0][m][1] * acc[ai][1][m][1] * r2;
                    u32x4 w; w.x = cvt_pk_bf16(v0[0], v0[1]); w.y = cvt_pk_bf16(v0[2], v0[3]); w.z = cvt_pk_bf16(v1[0], v1[1]); w.w = cvt_pk_bf16(v1[2], v1[3]);
                    *(u32x4*)(rowp + 512 + 128 * (u.pn - 4)) = w;
                } else {
#pragma unroll
                    for (int bj = 0; bj < 2; ++bj) { f32x4 v0 = acc[ai][bj][m][0] * r, v1 = acc[ai][bj][m][1] * r;
                        u32x4 w; w.x = cvt_pk_bf16(v0[0], v0[1]); w.y = cvt_pk_bf16(v0[2], v0[3]); w.z = cvt_pk_bf16(v1[0], v1[1]); w.w = cvt_pk_bf16(v1[2], v1[3]);
                        *(u32x4*)(rowp + 1024 + 256 * (u.pn - 8) + 128 * bj) = w; }
                }
            }
    }
};
struct EpiRes {
    static constexpr bool PERM = true, AFTER_DRAIN = false;
    static constexpr bool NEEDS_RS = false;
    const bf16_t* res; bf16_t* XB; float* ssout;
    __device__ __forceinline__ void operator()(const f32x4 (&acc)[2][2][4][2], const Unit& u, int ui, int wr, int wc, int fr, int fq) const {
        const int row0 = u.pm * BM + wr * 64 + fr, col0 = u.pn * BM + wc * 32 + 8 * fq;
        u32x4 rv[2][4][2];
#pragma unroll
        for (int ai = 0; ai < 2; ++ai)
#pragma unroll
            for (int m = 0; m < 4; ++m)
#pragma unroll
                for (int bj = 0; bj < 2; ++bj) rv[ai][m][bj] = *(const u32x4*)(res + (size_t)(row0 + ai * HALF + m * 16) * D + col0 + bj * HALF);
#pragma unroll
        for (int ai = 0; ai < 2; ++ai) {
#pragma unroll
            for (int m = 0; m < 4; ++m) {
                const int row = row0 + ai * HALF + m * 16; const size_t off = (size_t)row * D + col0; float q = 0.f;
#pragma unroll
                for (int bj = 0; bj < 2; ++bj) {
                    const u32x4 r = rv[ai][m][bj];
                    const f32x4 h0 = (f32x4){bf_lo(r.x), bf_hi(r.x), bf_lo(r.y), bf_hi(r.y)} + acc[ai][bj][m][0], h1 = (f32x4){bf_lo(r.z), bf_hi(r.z), bf_lo(r.w), bf_hi(r.w)} + acc[ai][bj][m][1];
                    q += (h0[0] * h0[0] + h0[1] * h0[1]) + (h0[2] * h0[2] + h0[3] * h0[3]) + (h1[0] * h1[0] + h1[1] * h1[1]) + (h1[2] * h1[2] + h1[3] * h1[3]);
                    u32x4 w; w.x = cvt_pk_bf16(h0[0], h0[1]); w.y = cvt_pk_bf16(h0[2], h0[3]); w.z = cvt_pk_bf16(h1[0], h1[1]); w.w = cvt_pk_bf16(h1[2], h1[3]);
                    *(u32x4*)(XB + off + bj * HALF) = w;
                }
                q += __shfl_xor(q, 16); q += __shfl_xor(q, 32);
                if (fq == 0) ssout[(size_t)row * 16 + u.pn * 4 + wc] = q;
            }
            asm volatile("" ::: "memory");
        }
    }
};
struct EpiResFinal {
    static constexpr bool PERM = true, AFTER_DRAIN = false, NEEDS_RS = false;
    const bf16_t* res; float* out; const float* gfin; unsigned* xq; unsigned* cnt; unsigned* tmo; LAS float* sl;
    __device__ __forceinline__ void operator()(f32x4 (&acc)[2][2][4][2], const Unit& u, int ui, int wr, int wc, int fr, int fq) const {
        const int row0 = u.pm * BM + wr * 64 + fr, col0 = u.pn * BM + wc * 32 + 8 * fq, tid = threadIdx.x;
        LAS float* part = sl; LAS float* rsT = sl + 1024;
#pragma unroll
        for (int ai = 0; ai < 2; ++ai) {
            u32x4 rv[4][2];
#pragma unroll
            for (int m = 0; m < 4; ++m)
#pragma unroll
                for (int bj = 0; bj < 2; ++bj) rv[m][bj] = *(const u32x4*)(res + (size_t)(row0 + ai * HALF + m * 16) * D + col0 + bj * HALF);
#pragma unroll
            for (int m = 0; m < 4; ++m) { float q = 0.f;
#pragma unroll
                for (int bj = 0; bj < 2; ++bj) { const u32x4 r = rv[m][bj];
                    const f32x4 h0 = (f32x4){bf_lo(r.x), bf_hi(r.x), bf_lo(r.y), bf_hi(r.y)} + acc[ai][bj][m][0], h1 = (f32x4){bf_lo(r.z), bf_hi(r.z), bf_lo(r.w), bf_hi(r.w)} + acc[ai][bj][m][1];
                    q += (h0[0] * h0[0] + h0[1] * h0[1]) + (h0[2] * h0[2] + h0[3] * h0[3]) + (h1[0] * h1[0] + h1[1] * h1[1]) + (h1[2] * h1[2] + h1[3] * h1[3]);
                    acc[ai][bj][m][0] = h0; acc[ai][bj][m][1] = h1; }
                q += __shfl_xor(q, 16); q += __shfl_xor(q, 32);
                if (fq == 0) part[(ai * HALF + wr * 64 + m * 16 + fr) * 4 + wc] = q; }
        }
        asm volatile("s_waitcnt lgkmcnt(0)" ::: "memory"); __builtin_amdgcn_s_barrier(); asm volatile("" ::: "memory");
        if (tid < 256) { const f32x4 p = *(const LAS f32x4*)(part + tid * 4);
            __hip_atomic_store(xq + (size_t)(u.pm * BM + tid) * 4 + u.pn, __builtin_bit_cast(unsigned, (p.x + p.y) + (p.z + p.w)), __ATOMIC_RELAXED, __HIP_MEMORY_SCOPE_AGENT); }
        asm volatile("s_waitcnt vmcnt(0)" ::: "memory"); __builtin_amdgcn_s_barrier(); asm volatile("" ::: "memory");
        if (tid == 0) { unsigned* c = cnt + 16 * u.pm; __hip_atomic_fetch_add(c, 1u, __ATOMIC_RELAXED, __HIP_MEMORY_SCOPE_AGENT);
            unsigned sp = 0u;
            while (__hip_atomic_load(c, __ATOMIC_RELAXED, __HIP_MEMORY_SCOPE_AGENT) < 4u) { __builtin_amdgcn_s_sleep(1);
                if ((++sp & 255u) == 0u) { if (__hip_atomic_load(tmo, __ATOMIC_RELAXED, __HIP_MEMORY_SCOPE_AGENT)) break; if (sp > (1u << 18)) { atomicAdd(tmo, 1u); break; } } }
            __builtin_amdgcn_fence(__ATOMIC_ACQUIRE, "agent"); asm volatile("s_waitcnt vmcnt(0)" ::: "memory"); }
        __builtin_amdgcn_s_barrier(); asm volatile("" ::: "memory");
        if (tid < 256) { const unsigned* p = xq + (size_t)(u.pm * BM + tid) * 4; float sm = 0.f;
#pragma unroll
            for (int t = 0; t < 4; ++t) sm += __builtin_bit_cast(float, __hip_atomic_load(p + t, __ATOMIC_RELAXED, __HIP_MEMORY_SCOPE_AGENT));
            rsT[tid] = __builtin_amdgcn_rsqf(sm * (1.0f / 1024.0f) + RMS_EPS); }
        asm volatile("s_waitcnt lgkmcnt(0)" ::: "memory"); __builtin_amdgcn_s_barrier(); asm volatile("" ::: "memory");
        f32x4 gv[2][2];
#pragma unroll
        for (int bj = 0; bj < 2; ++bj)
#pragma unroll
            for (int n = 0; n < 2; ++n) gv[bj][n] = *(const f32x4*)(gfin + col0 + bj * HALF + 4 * n);
#pragma unroll
        for (int ai = 0; ai < 2; ++ai)
#pragma unroll
            for (int m = 0; m < 4; ++m) { const int rl = ai * HALF + wr * 64 + m * 16 + fr; const float r = rsT[rl]; float* orow = out + (size_t)(u.pm * BM + rl) * D + col0;
#pragma unroll
                for (int bj = 0; bj < 2; ++bj)
#pragma unroll
                    for (int n = 0; n < 2; ++n) *(f32x4*)(orow + bj * HALF + 4 * n) = acc[ai][bj][m][n] * r * gv[bj][n]; }
    }
};
struct EpiHid {
    static constexpr bool PERM = true, AFTER_DRAIN = false;
    static constexpr bool NEEDS_RS = true;
    bf16_t* O; const float* ss; const LAS float* rs_tab;
    __device__ __forceinline__ void operator()(const f32x4 (&acc)[2][2][4][2], const Unit& u, int ui, int wr, int wc, int fr, int fq) const {
        const LAS float* rsp = rs_tab + ui * 256 + wr * 64 + fr; float rsv[2][4];
#pragma unroll
        for (int ai = 0; ai < 2; ++ai)
#pragma unroll
            for (int m = 0; m < 4; ++m) rsv[ai][m] = rsp[ai * HALF + m * 16];
        const int row0 = u.pm * BM + wr * 64 + fr, col0 = u.pn * BM + wc * 32 + 8 * fq;
#pragma unroll
        for (int ai = 0; ai < 2; ++ai)
#pragma unroll
            for (int m = 0; m < 4; ++m) {
                const int row = row0 + ai * HALF + m * 16; const float r = rsv[ai][m], r2 = r * r;
                bf16_t* rowp = O + (size_t)row * FF + col0;
#pragma unroll
                for (int bj = 0; bj < 2; ++bj) {
                    f32x4 v0, v1;
#pragma unroll
                    for (int j = 0; j < 4; ++j) { v0[j] = relu1(acc[ai][bj][m][0][j]); v1[j] = relu1(acc[ai][bj][m][1][j]); }
                    v0 = v0 * v0 * r2; v1 = v1 * v1 * r2;
                    u32x4 w; w.x = cvt_pk_bf16(v0[0], v0[1]); w.y = cvt_pk_bf16(v0[2], v0[3]); w.z = cvt_pk_bf16(v1[0], v1[1]); w.w = cvt_pk_bf16(v1[2], v1[3]);
                    __builtin_nontemporal_store(w, (u32x4*)(rowp + bj * HALF)); }
            }
    }
};
struct EpiInOdd {
    static constexpr bool PERM = true, AFTER_DRAIN = false;
    static constexpr bool NEEDS_RS = true;
    bf16_t* U; bf16_t* V; const float* ss; const float* bias; f32x2* vst; const LAS float* rs_tab;
    __device__ __forceinline__ void operator()(const f32x4 (&acc)[2][2][4][2], const Unit& u, int ui, int wr, int wc, int fr, int fq) const {
        const LAS float* rsp = rs_tab + ui * 256 + wr * 64 + fr; float rsv[2][4];
#pragma unroll
        for (int ai = 0; ai < 2; ++ai)
#pragma unroll
            for (int m = 0; m < 4; ++m) rsv[ai][m] = rsp[ai * HALF + m * 16];
        const int row0 = u.pm * BM + wr * 64 + fr, colt = wc * 32 + 8 * fq; const bool isv = u.pn >= 4;
        bf16_t* base = isv ? V : U; const int col0 = (isv ? u.pn - 4 : u.pn) * BM + colt;
        f32x4 bv[2][2];
#pragma unroll
        for (int bj = 0; bj < 2; ++bj)
#pragma unroll
            for (int n = 0; n < 2; ++n) bv[bj][n] = *(const f32x4*)(bias + u.pn * BM + colt + bj * HALF + 4 * n);
#pragma unroll
        for (int ai = 0; ai < 2; ++ai)
#pragma unroll
            for (int m = 0; m < 4; ++m) {
                const int row = row0 + ai * HALF + m * 16; const float r = rsv[ai][m]; float s = 0.f, q = 0.f;
                bf16_t* rowp = base + (size_t)row * D + col0;
#pragma unroll
                for (int bj = 0; bj < 2; ++bj) {
                    f32x4 v0 = acc[ai][bj][m][0] * r + bv[bj][0], v1 = acc[ai][bj][m][1] * r + bv[bj][1];
                    f32x2 a = gelu_pk((f32x2){v0[0], v0[1]}), b = gelu_pk((f32x2){v0[2], v0[3]}), c = gelu_pk((f32x2){v1[0], v1[1]}), d = gelu_pk((f32x2){v1[2], v1[3]});
                    s += (a.x + a.y) + (b.x + b.y) + (c.x + c.y) + (d.x + d.y);
                    q += (a.x * a.x + a.y * a.y) + (b.x * b.x + b.y * b.y) + (c.x * c.x + c.y * c.y) + (d.x * d.x + d.y * d.y);
                    u32x4 w; w.x = cvt_pk_bf16(a.x, a.y); w.y = cvt_pk_bf16(b.x, b.y); w.z = cvt_pk_bf16(c.x, c.y); w.w = cvt_pk_bf16(d.x, d.y);
                    *(u32x4*)(rowp + bj * HALF) = w; }
                if (isv) { s += __shfl_xor(s, 16); s += __shfl_xor(s, 32); q += __shfl_xor(q, 16); q += __shfl_xor(q, 32);
                    if (fq == 0) vst[(size_t)row * 16 + (u.pn - 4) * 4 + wc] = (f32x2){s, q}; }
            }
    }
};

template <class Epi, class Sched, bool ALIGN_EPI = false, bool SP2 = false>
__device__ __forceinline__ void gemm_phase(LAS unsigned char* lds, const Gemm g, const Sched& S, const Epi& E) {
    int tid_ = threadIdx.x; asm volatile("" : "+v"(tid_));
    const int tid = tid_, wid = __builtin_amdgcn_readfirstlane(tid >> 6), lane = tid & 63, wr = wid >> 2, wc = wid & 3, fr = lane & 15, fq = lane >> 4;
    const int K = g.K, nt = K / BK;
    unsigned voffA[2], voffB[2];
#pragma unroll
    for (int i = 0; i < 2; ++i) { int R, C; stage_rc(tid * 16 + i * 8192, R, C); const int Rb = Epi::PERM ? ((R & ~31) + perm32(R & 31)) : R;
        voffA[i] = (unsigned)(R * K + C) * 2u; voffB[i] = (unsigned)(Rb * K + C) * 2u; }
    const size_t kstep = (size_t)(BK * 2);
    const size_t hstep = (size_t)HALF * K * 2;
    const size_t tstep = 2 * hstep;
    const unsigned ldsw = (unsigned)wid * 1024u;
    const int aoff = lds_byte(wr * 64 + fr, fq * 8), boff = lds_byte(wc * 32 + fr, fq * 8);
#define PG8_SA(b, h) (((b) * 2 + (h)) * HTB)
#define PG8_SB(b, h) ((4 + (b) * 2 + (h)) * HTB)
#define PG8_STAGE(bufoff, gbase, voff) do { _Pragma("unroll") for (int _i = 0; _i < 2; ++_i) \
        __builtin_amdgcn_global_load_lds((const unsigned*)((const char*)(gbase) + (voff)[_i]), (LAS unsigned*)(lds + (bufoff) + ldsw + _i * 8192), 16, 0, 0); } while (0)
#define PG8_LDA(dst, b, h) do { _Pragma("unroll") for (int m = 0; m < 4; ++m) _Pragma("unroll") for (int k = 0; k < 2; ++k) dst[m][k] = *(const LAS bf16x8*)(lds + PG8_SA(b, h) + aoff + m * 2048 + k * 1024); } while (0)
#define PG8_LDB(dst, b, h) do { _Pragma("unroll") for (int n = 0; n < 2; ++n) _Pragma("unroll") for (int k = 0; k < 2; ++k) dst[n][k] = *(const LAS bf16x8*)(lds + PG8_SB(b, h) + boff + n * 2048 + k * 1024); } while (0)
#define PG8_MMA(ai, bj, At, Bt) do { __builtin_amdgcn_s_setprio(1); _Pragma("unroll") for (int m = 0; m < 4; ++m) _Pragma("unroll") for (int n = 0; n < 2; ++n) _Pragma("unroll") for (int k = 0; k < 2; ++k) \
        acc[ai][bj][m][n] = __builtin_amdgcn_mfma_f32_16x16x32_bf16(Bt[n][k], At[m][k], acc[ai][bj][m][n], 0, 0, 0); __builtin_amdgcn_s_setprio(0); } while (0)
#define PG8_WAIT_V(n) asm volatile("s_waitcnt vmcnt(" #n ")" ::: "memory")
#define PG8_WAIT_L(n) asm volatile("s_waitcnt lgkmcnt(" #n ")" ::: "memory")
#define PG8_BAR __builtin_amdgcn_s_barrier()
#define PG8_SCHED __builtin_amdgcn_sched_barrier(0)
    Unit cur, nxt; int ui = 0;
    if (!S.next(0, cur)) return;
    f32x4 acc[2][2][4][2];
#pragma unroll
    for (int a = 0; a < 2; ++a)
#pragma unroll
        for (int b = 0; b < 2; ++b)
#pragma unroll
            for (int m = 0; m < 4; ++m)
#pragma unroll
                for (int n = 0; n < 2; ++n) acc[a][b][m][n] = (f32x4){0.f, 0.f, 0.f, 0.f};
    bf16x8 At[4][2], B0[2][2], B1[2][2];
    const char* cA = (const char*)g.A + (size_t)cur.pm * tstep; const char* cB = (const char*)g.Bt + (size_t)cur.pn * tstep;
    if constexpr (SP2) {
        PG8_STAGE(PG8_SB(0, 0), cB, voffB); PG8_STAGE(PG8_SB(0, 1), cB + hstep, voffB); PG8_STAGE(PG8_SA(0, 0), cA, voffA); PG8_STAGE(PG8_SA(0, 1), cA + hstep, voffA);
        if constexpr (Epi::NEEDS_RS) {
            LAS float* tab = (LAS float*)(lds + STAGE_BYTES + 256); Unit pu;
            for (int i = tid >> 8; S.next(i, pu); i += 2) tab[i * 256 + (tid & 255)] = row_rs(E.ss, pu.pm * BM + (tid & 255));
            PG8_WAIT_L(0);
        }
        if (wr == 1) PG8_BAR;
        PG8_WAIT_V(2); PG8_BAR;
        PG8_STAGE(PG8_SB(1, 0), cB + kstep, voffB); PG8_STAGE(PG8_SA(1, 0), cA + kstep, voffA); PG8_STAGE(PG8_SB(1, 1), cB + hstep + kstep, voffB);
        PG8_WAIT_V(6); PG8_BAR;
    } else {
        PG8_STAGE(PG8_SB(0, 0), cB, voffB); PG8_STAGE(PG8_SA(0, 0), cA, voffA); PG8_STAGE(PG8_SB(0, 1), cB + hstep, voffB); PG8_STAGE(PG8_SA(0, 1), cA + hstep, voffA);
        if (wr == 1) PG8_BAR;
        PG8_WAIT_V(4); PG8_BAR;
        PG8_STAGE(PG8_SB(1, 0), cB + kstep, voffB); PG8_STAGE(PG8_SA(1, 0), cA + kstep, voffA); PG8_STAGE(PG8_SB(1, 1), cB + hstep + kstep, voffB);
        PG8_WAIT_V(6); PG8_BAR;
    }
    for (;;) {
        const bool has_next = S.next(ui + 1, nxt);
        const char* nA = has_next ? (const char*)g.A + (size_t)nxt.pm * tstep : cA; const char* nB = has_next ? (const char*)g.Bt + (size_t)nxt.pn * tstep : cB;
        for (int t = 0; t < nt; t += 2) {
            const bool last = (t == nt - 2);
            const char* a1 = cA + (size_t)(t + 1) * kstep;
            const char* a2 = last ? nA : cA + (size_t)(t + 2) * kstep; const char* b2 = last ? nB : cB + (size_t)(t + 2) * kstep;
            const char* a3 = a2 + kstep; const char* b3 = b2 + kstep;
            if constexpr (SP2) {
            PG8_LDB(B0, 0, 0); PG8_LDB(B1, 0, 1); PG8_SCHED; PG8_LDA(At, 0, 0); PG8_STAGE(PG8_SA(1, 1), a1 + hstep, voffA);
            PG8_WAIT_V(8); PG8_WAIT_L(0); PG8_BAR; PG8_MMA(0, 0, At, B0); PG8_MMA(0, 1, At, B1); PG8_BAR; PG8_SCHED;
            PG8_LDA(At, 0, 1); PG8_STAGE(PG8_SB(0, 0), b2, voffB); PG8_STAGE(PG8_SB(0, 1), b2 + hstep, voffB); PG8_STAGE(PG8_SA(0, 0), a2, voffA);
            PG8_WAIT_V(8); PG8_WAIT_L(0); PG8_BAR; PG8_MMA(1, 0, At, B0); PG8_MMA(1, 1, At, B1); PG8_BAR; PG8_SCHED;
            PG8_LDB(B0, 1, 0); PG8_LDB(B1, 1, 1); PG8_SCHED; PG8_LDA(At, 1, 0); PG8_STAGE(PG8_SA(0, 1), a2 + hstep, voffA);
            PG8_WAIT_V(8); PG8_WAIT_L(0); PG8_BAR; PG8_MMA(0, 0, At, B0); PG8_MMA(0, 1, At, B1); PG8_BAR; PG8_SCHED;
            PG8_LDA(At, 1, 1); PG8_STAGE(PG8_SB(1, 0), b3, voffB); PG8_STAGE(PG8_SB(1, 1), b3 + hstep, voffB); PG8_STAGE(PG8_SA(1, 0), a3, voffA);
            PG8_WAIT_V(8); PG8_WAIT_L(0); PG8_BAR; PG8_MMA(1, 0, At, B0); PG8_MMA(1, 1, At, B1); PG8_BAR; PG8_SCHED;
            } else {
            PG8_LDB(B0, 0, 0); PG8_SCHED; PG8_LDA(At, 0, 0); PG8_STAGE(PG8_SA(1, 1), a1 + hstep, voffA);
            PG8_WAIT_L(8); PG8_BAR; PG8_WAIT_L(0); PG8_MMA(0, 0, At, B0); PG8_BAR; PG8_SCHED;
            PG8_LDB(B1, 0, 1); PG8_STAGE(PG8_SB(0, 0), b2, voffB);
            PG8_BAR; PG8_WAIT_L(0); PG8_MMA(0, 1, At, B1); PG8_BAR;
            PG8_LDA(At, 0, 1); PG8_STAGE(PG8_SA(0, 0), a2, voffA);
            PG8_BAR; PG8_WAIT_L(0); PG8_MMA(1, 0, At, B0); PG8_BAR; PG8_SCHED;
            PG8_STAGE(PG8_SB(0, 1), b2 + hstep, voffB);
            PG8_WAIT_V(6); PG8_BAR; PG8_MMA(1, 1, At, B1); PG8_BAR;
            PG8_LDB(B0, 1, 0); PG8_SCHED; PG8_LDA(At, 1, 0); PG8_STAGE(PG8_SA(0, 1), a2 + hstep, voffA);
            PG8_WAIT_L(8); PG8_BAR; PG8_WAIT_L(0); PG8_MMA(0, 0, At, B0); PG8_BAR; PG8_SCHED;
            PG8_LDB(B1, 1, 1); PG8_STAGE(PG8_SB(1, 0), b3, voffB);
            PG8_BAR; PG8_WAIT_L(0); PG8_MMA(0, 1, At, B1); PG8_BAR;
            PG8_LDA(At, 1, 1); PG8_STAGE(PG8_SA(1, 0), a3, voffA);
            PG8_BAR; PG8_WAIT_L(0); PG8_MMA(1, 0, At, B0); PG8_BAR; PG8_SCHED;
            PG8_STAGE(PG8_SB(1, 1), b3 + hstep, voffB);
            PG8_WAIT_V(6); PG8_BAR; PG8_MMA(1, 1, At, B1); PG8_BAR;
            }
        }
        if constexpr (ALIGN_EPI) { if (wr == 0) PG8_BAR; }
        E(acc, cur, ui, wr, wc, fr, fq);
        if (!has_next) break;
#pragma unroll
        for (int a = 0; a < 2; ++a)
#pragma unroll
            for (int b = 0; b < 2; ++b)
#pragma unroll
                for (int m = 0; m < 4; ++m)
#pragma unroll
                    for (int n = 0; n < 2; ++n) acc[a][b][m][n] = (f32x4){0.f, 0.f, 0.f, 0.f};
        cur = nxt; cA = nA; cB = nB; ++ui;
        if constexpr (ALIGN_EPI) { if (wr == 1) PG8_BAR; }
    }
    PG8_WAIT_V(0);
    if constexpr (!ALIGN_EPI) { if (wr == 0) PG8_BAR; }
    PG8_BAR;
#undef PG8_SA
#undef PG8_SB
#undef PG8_STAGE
#undef PG8_LDA
#undef PG8_LDB
#undef PG8_MMA
#undef PG8_WAIT_V
#undef PG8_WAIT_L
#undef PG8_BAR
#undef PG8_SCHED
}
}

constexpr int NWAVES = 8, NTHR = 512;
constexpr int LDS_BYTES = 131072 + 256 + 16 * 1024;
#define LDS_WAIT() asm volatile("s_waitcnt lgkmcnt(0)" ::: "memory")

__device__ __forceinline__ void tr_item(const float* W, int K, int N, bf16_t* WT, const float* gain, int mode, LAS float* scr, int item, int lane) {
    const int nblk = N / 64, kb = item / nblk, nb = item % nblk, k0 = 64 * kb, n0 = 64 * nb;
    int ns = n0;
    if (mode) { const int t = n0 >> 8, j = n0 & 255;
        if (t < 4) ns = (j < 128) ? 128 * t + j : 512 + 128 * t + (j - 128);
        else if (t < 8) ns = (j < 128) ? 1536 + 128 * (t - 4) + j : 2048 + 128 * (t - 4) + (j - 128);
        else ns = 1024 + 256 * (t - 8) + j; }
    const int r4 = lane >> 4, c4 = (lane & 15) * 4;
    f32x4 v[16];
#pragma unroll
    for (int i = 0; i < 16; ++i) v[i] = __builtin_nontemporal_load((const f32x4*)(W + (size_t)(k0 + 4 * i + r4) * N + ns + c4));
    if (gain) {
#pragma unroll
        for (int i = 0; i < 16; ++i) v[i] = v[i] * gain[k0 + 4 * i + r4];
    }
    const int c = lane & 7;
#pragma unroll
    for (int h = 0; h < 2; ++h) {
        if (((lane & 15) >> 3) == h) { const int cc = c4 - 32 * h;
#pragma unroll
            for (int i = 0; i < 16; ++i) { LAS float* d = scr + (4 * i + r4) * 33 + cc; d[0] = v[i][0]; d[1] = v[i][1]; d[2] = v[i][2]; d[3] = v[i][3]; } }
        LDS_WAIT(); asm volatile("" ::: "memory");
#pragma unroll
        for (int j = 0; j < 4; ++j) { const int n = (lane >> 3) + 8 * j; const LAS float* sp = scr + (8 * c) * 33 + n;
            u32x4 o; o.x = cvt_pk_bf16(sp[0 * 33], sp[1 * 33]); o.y = cvt_pk_bf16(sp[2 * 33], sp[3 * 33]); o.z = cvt_pk_bf16(sp[4 * 33], sp[5 * 33]); o.w = cvt_pk_bf16(sp[6 * 33], sp[7 * 33]);
            *(u32x4*)(WT + (size_t)(n0 + 32 * h + n) * K + k0 + 8 * c) = o; }
        LDS_WAIT(); asm volatile("" ::: "memory");
    }
}

struct Params { const float* in[21]; float* out; unsigned char* ws; };

constexpr int CR = 16;
template <int J, int I> __device__ __forceinline__ void conv_tap(f32x2 (&acc)[CR], const f32x2 (&w)[31], f32x2 x) {
    if constexpr (J - I >= 0 && J - I <= 30) acc[I] += w[J - I] * x;
}
template <int J, int... I> __device__ __forceinline__ void conv_row(f32x2 (&acc)[CR], const f32x2 (&w)[31], f32x2 x, std::integer_sequence<int, I...>) { (conv_tap<J, I>(acc, w, x), ...); }
template <int J> __device__ __forceinline__ void conv_j(f32x2 (&acc)[CR], const f32x2 (&w)[31], const unsigned (&xw)[CR + 30]) {
    const unsigned xv = xw[J];
    conv_row<J>(acc, w, (f32x2){bf_lo(xv), bf_hi(xv)}, std::make_integer_sequence<int, CR>{});
}
template <int... J> __device__ __forceinline__ void conv_all(f32x2 (&acc)[CR], const f32x2 (&w)[31], const unsigned (&xw)[CR + 30], std::integer_sequence<int, J...>) { (conv_j<J>(acc, w, xw), ...); }
template <int OFF, int... J> __device__ __forceinline__ void conv_load(unsigned (&xw)[CR + 30], const bf16_t* src, int tl, std::integer_sequence<int, J...>) {
    ((xw[OFF + J] = (tl - 30 + OFF + J >= 0) ? *(const unsigned*)(src + (size_t)(OFF + J) * NG1) : 0u), ...);
}
constexpr int CV_EARLY = 24;
__device__ __forceinline__ float xreduce16(const float (&v)[16], int lane) {
    float b[8], c[4], d[2], e;
    { const bool up = lane & 32;
#pragma unroll
      for (int i = 0; i < 8; ++i) { const float keep = up ? v[i + 8] : v[i], send = up ? v[i] : v[i + 8]; b[i] = keep + __shfl_xor(send, 32); } }
    { const bool up = lane & 16;
#pragma unroll
      for (int i = 0; i < 4; ++i) { const float keep = up ? b[i + 4] : b[i], send = up ? b[i] : b[i + 4]; c[i] = keep + __shfl_xor(send, 16); } }
    { const bool up = lane & 8;
#pragma unroll
      for (int i = 0; i < 2; ++i) { const float keep = up ? c[i + 2] : c[i], send = up ? c[i] : c[i + 2]; d[i] = keep + __shfl_xor(send, 8); } }
    { const bool up = lane & 4; const float keep = up ? d[1] : d[0], send = up ? d[0] : d[1]; e = keep + __shfl_xor(send, 4); }
    e += __shfl_xor(e, 2); e += __shfl_xor(e, 1);
    return e;
}

__device__ __forceinline__ void conv_phase(const Params& P, const bf16_t* G1, bf16_t* MX, LAS unsigned char* lds, int NGRP, int xg, int xr, int XR) {
    const float* caw = P.in[3]; const float* cab = P.in[4]; const float* lng = P.in[5]; const float* lnb = P.in[6]; const float* cbw = P.in[7];
    int tid_ = threadIdx.x; asm volatile("" : "+v"(tid_));
    const int tid = tid_, grp = tid >> 8, t8 = tid & 255, lane = tid & 63, wv = (tid >> 6) & 3;
    const int c0 = 2 * t8;
    LAS float* red = (LAS float*)lds;
    LAS float* st = (LAS float*)(lds + 4096);
    f32x2 w[31];
#pragma unroll
    for (int k = 0; k < 31; ++k) w[k] = *(const f32x2*)(caw + k * 512 + c0);
    const f32x2 cb = *(const f32x2*)(cab + c0), lg = *(const f32x2*)(lng + c0), lb = *(const f32x2*)(lnb + c0);
    const f32x2 wb0 = *(const f32x2*)(cbw + c0), wb1 = *(const f32x2*)(cbw + 512 + c0), wb2 = *(const f32x2*)(cbw + 1024 + c0);
    const int per_grp = (M / 32) / NGRP, nit = (per_grp - xr + XR - 1) / XR;
#define CV_BAR() do { asm volatile("s_waitcnt lgkmcnt(0)" ::: "memory"); __builtin_amdgcn_s_barrier(); asm volatile("" ::: "memory"); } while (0)
#define CV_T0(k_) ((xg * per_grp + xr + (k_) * XR) * 32 + grp * CR)
#define CV_LOAD(XW, k_) do { const int t0_ = CV_T0(k_); conv_load<0>(XW, G1 + (size_t)(t0_ - 30) * NG1 + c0, t0_ & (SEQ - 1), std::make_integer_sequence<int, CV_EARLY>{}); } while (0)
#define CV_BODY(XW, k_) do { const int t0 = CV_T0(k_), tl = t0 & (SEQ - 1); \
        conv_load<CV_EARLY>(XW, G1 + (size_t)(t0 - 30) * NG1 + c0, tl, std::make_integer_sequence<int, CR + 30 - CV_EARLY>{}); \
        f32x2 acc[CR]; \
        _Pragma("unroll") for (int i = 0; i < CR; ++i) acc[i] = cb; \
        conv_all(acc, w, XW, std::make_integer_sequence<int, CR + 30>{}); \
        const bf16_t* ps = G1 + (size_t)t0 * NG1 + 512 + c0; const bf16_t* bg = G1 + (size_t)t0 * NG1 + 1024 + c0; \
        unsigned pa = 0u, pb = 0u; if (tl != 0) { pa = *(const unsigned*)(ps - 2 * (size_t)NG1); pb = *(const unsigned*)(ps - (size_t)NG1); } \
        float S, Q; \
        { float sv[CR]; _Pragma("unroll") for (int i = 0; i < CR; ++i) sv[i] = acc[i].x + acc[i].y; S = xreduce16(sv, lane); } \
        { float qv[CR]; _Pragma("unroll") for (int i = 0; i < CR; ++i) qv[i] = acc[i].x * acc[i].x + acc[i].y * acc[i].y; Q = xreduce16(qv, lane); } \
        if ((lane & 3) == 0) *(LAS f32x2*)(red + ((grp * 4 + wv) * CR + (lane >> 2)) * 2) = (f32x2){S, Q}; \
        CV_BAR(); \
        if (t8 < CR) { float s_ = 0.f, q_ = 0.f; \
            _Pragma("unroll") for (int x = 0; x < 4; ++x) { const f32x2 t = *(const LAS f32x2*)(red + ((grp * 4 + x) * CR + t8) * 2); s_ += t.x; q_ += t.y; } \
            const float mean = s_ * (1.0f / 512.0f), var = q_ * (1.0f / 512.0f) - mean * mean; \
            *(LAS f32x2*)(st + (grp * CR + t8) * 2) = (f32x2){mean, __builtin_amdgcn_rsqf(var + LN_EPS)}; } \
        CV_BAR(); \
        bf16_t* dst = MX + (size_t)t0 * D + c0; \
        _Pragma("unroll") for (int i = 0; i < CR; ++i) { const f32x2 ms = *(const LAS f32x2*)(st + (grp * CR + i) * 2); \
            const float y0 = (acc[i].x - ms.x) * ms.y * lg.x + lb.x, y1 = (acc[i].y - ms.x) * ms.y * lg.y + lb.y; \
            *(unsigned*)(dst + (size_t)i * D) = cvt_pk_bf16(y0 * fast_sigmoid(y0), y1 * fast_sigmoid(y1)); } \
          \
        float p2x = bf_lo(pa), p2y = bf_hi(pa), p1x = bf_lo(pb), p1y = bf_hi(pb); \
        _Pragma("unroll") for (int i = 0; i < CR; ++i) { const unsigned pvi = __builtin_nontemporal_load((const unsigned*)(ps + (size_t)i * NG1)), gvi = __builtin_nontemporal_load((const unsigned*)(bg + (size_t)i * NG1)); const float px = bf_lo(pvi), py = bf_hi(pvi); \
            const float ox = bf_lo(gvi) * (wb0.x * p2x + wb1.x * p1x + wb2.x * px), oy = bf_hi(gvi) * (wb0.y * p2y + wb1.y * p1y + wb2.y * py); \
            *(unsigned*)(dst + (size_t)i * D + 512) = cvt_pk_bf16(ox, oy); \
            p2x = p1x; p2y = p1y; p1x = px; p1y = py; } } while (0)
    unsigned xa[CR + 30], xb[CR + 30];
    if (nit > 0) CV_LOAD(xa, 0);
    for (int k = 0; k < nit; k += 2) {
        const bool has1 = k + 1 < nit, has2 = k + 2 < nit;
        if (has1) CV_LOAD(xb, k + 1);
        CV_BODY(xa, k);
        if (has1) { if (has2) CV_LOAD(xa, k + 2); CV_BODY(xb, k + 1); }
    }
#undef CV_BAR
#undef CV_T0
#undef CV_LOAD
#undef CV_BODY
}

constexpr int SG_STRIDE = 272, SG_TILE = 128 * SG_STRIDE, SG_STAT = 0, SG_GAIN = 16384, SG_TILES = 24576;
__device__ __forceinline__ void sgu_phase(const Params& P, const bf16_t* U, const bf16_t* V, bf16_t* Y, LAS unsigned char* lds, int NGRP, int xg, int xr, int XR) {
    const f32x2* VST = (const f32x2*)(P.ws + WS_VST); const bf16_t* WSB = (const bf16_t*)(P.ws + WS_WSB);
    const float* lvg = P.in[12]; const float* lvb = P.in[13]; const float* bs = P.in[15];
    int tid_ = threadIdx.x; asm volatile("" : "+v"(tid_));
    const int tid = tid_, wid = __builtin_amdgcn_readfirstlane(tid >> 6), lane = tid & 63, fr = lane & 15, fq = lane >> 4;
    const int wt = wid >> 1, wcn = wid & 1;
    LAS float* stat = (LAS float*)(lds + SG_STAT);
    LAS float* gain = (LAS float*)(lds + SG_GAIN);
    LAS unsigned char* tiles = lds + SG_TILES;
    const int lr = tid >> 4, lc = tid & 15;
    const int trb = ((lane & 15) >> 2) * SG_STRIDE + (lane & 3) * 8 + fq * 8 * SG_STRIDE + wcn * 128;
    const int per_grp = (M / 128) / NGRP, vblk = xg * per_grp + xr, G = XR;
    int nch = (per_grp - xr + XR - 1) / XR; if (nch > 16) nch = 16;
    const int NIT = nch * 8;
    for (int i = tid; i < nch * 128; i += NTHR) { const int row = (vblk + G * (i >> 7)) * 128 + (i & 127);
        const f32x4* p = (const f32x4*)(VST + (size_t)row * 16); float sm = 0.f, q = 0.f;
#pragma unroll
        for (int x = 0; x < 8; ++x) { const f32x4 t = p[x]; sm += t.x + t.z; q += t.y + t.w; }
        const float mean = sm * (1.0f / 1024.0f), var = q * (1.0f / 1024.0f) - mean * mean;
        *(LAS f32x2*)(stat + i * 2) = (f32x2){mean, __builtin_amdgcn_rsqf(var + LN_EPS)}; }
    for (int i = tid; i < 1024; i += NTHR) { gain[i] = lvg[i]; gain[1024 + i] = lvb[i]; }
    u32x4 vr[4]; bf16x8 af[2][4]; u32x2 ur[2][4]; float bsv[2];
#define SG_LOAD(n_, VR, AF, UR, BSV, LDA_) do { const int g_ = (n_) / nch, row0_ = (vblk + G * ((n_) - g_ * nch)) * 128; \
        _Pragma("unroll") for (int i = 0; i < 4; ++i) VR[i] = __builtin_nontemporal_load((const u32x4*)(V + (size_t)(row0_ + lr + 32 * i) * D + g_ * 128 + lc * 8)); \
        const bf16_t* wsg_ = WSB + (size_t)(g_ * 128 + 32 * wt + fr) * 128 + 8 * fq; \
        if (LDA_) { _Pragma("unroll") for (int mb = 0; mb < 2; ++mb) { _Pragma("unroll") for (int kk = 0; kk < 4; ++kk) AF[mb][kk] = *(const bf16x8*)(wsg_ + (size_t)(16 * mb) * 128 + 32 * kk); } } \
        _Pragma("unroll") for (int mb = 0; mb < 2; ++mb) { \
            const int tloc_ = 32 * wt + 16 * mb + fr; const size_t ro_ = (size_t)(row0_ + tloc_) * D + g_ * 128 + 64 * wcn + 4 * fq; BSV[mb] = bs[g_ * 128 + tloc_]; \
            _Pragma("unroll") for (int nb = 0; nb < 4; ++nb) UR[mb][nb] = __builtin_nontemporal_load((const u32x2*)(U + ro_ + 16 * nb)); } } while (0)
    SG_LOAD(0, vr, af, ur, bsv, true);
    __syncthreads();
    for (int n = 0; n < NIT; ++n) {
        const int g = n / nch, ci = n - g * nch, row0 = (vblk + G * ci) * 128;
        LAS unsigned char* tile = tiles + (n & 1) * SG_TILE;
        { const f32x4 g0 = *(const LAS f32x4*)(gain + g * 128 + lc * 8), g1 = *(const LAS f32x4*)(gain + g * 128 + lc * 8 + 4);
          const f32x4 b0 = *(const LAS f32x4*)(gain + 1024 + g * 128 + lc * 8), b1 = *(const LAS f32x4*)(gain + 1024 + g * 128 + lc * 8 + 4);
#pragma unroll
          for (int i = 0; i < 4; ++i) { const int rr = lr + 32 * i; const f32x2 ms = *(const LAS f32x2*)(stat + (ci * 128 + rr) * 2);
            const u32x4 raw = vr[i]; const float mu = ms.x, rs = ms.y;
            u32x4 o;
            o.x = cvt_pk_bf16((bf_lo(raw.x) - mu) * rs * g0[0] + b0[0], (bf_hi(raw.x) - mu) * rs * g0[1] + b0[1]);
            o.y = cvt_pk_bf16((bf_lo(raw.y) - mu) * rs * g0[2] + b0[2], (bf_hi(raw.y) - mu) * rs * g0[3] + b0[3]);
            o.z = cvt_pk_bf16((bf_lo(raw.z) - mu) * rs * g1[0] + b1[0], (bf_hi(raw.z) - mu) * rs * g1[1] + b1[1]);
            o.w = cvt_pk_bf16((bf_lo(raw.w) - mu) * rs * g1[2] + b1[2], (bf_hi(raw.w) - mu) * rs * g1[3] + b1[3]);
            *(LAS u32x4*)(tile + rr * SG_STRIDE + lc * 16) = o; } }
        __syncthreads();
        u32x4 vrn[4]; bf16x8 afn[2][4]; u32x2 urn[2][4]; float bsn[2];
        { const int nn = (n + 1 < NIT) ? n + 1 : n; const bool newg = (nn / nch) != g;
#pragma unroll
          for (int mb = 0; mb < 2; ++mb)
#pragma unroll
              for (int k = 0; k < 4; ++k) afn[mb][k] = af[mb][k];
          SG_LOAD(nn, vrn, afn, urn, bsn, newg); }
        f32x4 acc[2][4];
#pragma unroll
        for (int mb = 0; mb < 2; ++mb)
#pragma unroll
            for (int nb = 0; nb < 4; ++nb) acc[mb][nb] = (f32x4){0.f, 0.f, 0.f, 0.f};
#pragma unroll
        for (int kk = 0; kk < 4; ++kk) {
#pragma unroll
            for (int nb = 0; nb < 4; ++nb) {
                const LAS unsigned char* tp = tile + trb + kk * 32 * SG_STRIDE + nb * 32;
                const s16x4 lo = __builtin_amdgcn_ds_read_tr16_b64_v4i16((LAS s16x4*)(tp));
                const s16x4 hi = __builtin_amdgcn_ds_read_tr16_b64_v4i16((LAS s16x4*)(tp + 4 * SG_STRIDE));
                const bf16x8 bf = __builtin_shufflevector(lo, hi, 0, 1, 2, 3, 4, 5, 6, 7);
#pragma unroll
                for (int mb = 0; mb < 2; ++mb) acc[mb][nb] = __builtin_amdgcn_mfma_f32_16x16x32_bf16(bf, af[mb][kk], acc[mb][nb], 0, 0, 0);
            }
        }
#pragma unroll
        for (int mb = 0; mb < 2; ++mb) { const int tloc = 32 * wt + 16 * mb + fr;
            const size_t ro = (size_t)(row0 + tloc) * D + g * 128 + 64 * wcn + 4 * fq;
#pragma unroll
            for (int nb = 0; nb < 4; ++nb) { const u32x2 uv = ur[mb][nb]; const f32x4 a = acc[mb][nb]; const float bb = bsv[mb];
                u32x2 o; o.x = cvt_pk_bf16(bf_lo(uv.x) * (a[0] + bb), bf_hi(uv.x) * (a[1] + bb)); o.y = cvt_pk_bf16(bf_lo(uv.y) * (a[2] + bb), bf_hi(uv.y) * (a[3] + bb));
                *(u32x2*)(Y + ro + 16 * nb) = o; } }
#pragma unroll
        for (int i = 0; i < 4; ++i) vr[i] = vrn[i];
#pragma unroll
        for (int mb = 0; mb < 2; ++mb) { bsv[mb] = bsn[mb];
#pragma unroll
            for (int k = 0; k < 4; ++k) { af[mb][k] = afn[mb][k]; ur[mb][k] = urn[mb][k]; } }
    }
#undef SG_LOAD
}

#define XB_TMO      128
#define XB_XCNT(j)  (256  + 64 * (j))
#define XB_XSUB(j)  (1280 + 64 * (j))
#define XB_XGEN(j)  (2304 + 64 * (j))
#define XB_TOP      3328
#define XB_TOPGEN   3392
#define XB_LSUB(j)  (3456 + 64 * (j))
#define XB_PCNT(pm) (4480 + 16 * (pm))
#define XCD_BAR_WORDS (4480 + 16 * 128)
#define XB_SPIN_CAP (1u << 18)
__device__ __forceinline__ unsigned xb_ld(unsigned* p)              { return __hip_atomic_load(p, __ATOMIC_RELAXED, __HIP_MEMORY_SCOPE_AGENT); }
__device__ __forceinline__ unsigned xb_add(unsigned* p, unsigned v) { return __hip_atomic_fetch_add(p, v, __ATOMIC_RELAXED, __HIP_MEMORY_SCOPE_AGENT); }
__device__ __forceinline__ unsigned xb_xcc_id() { return (unsigned)__builtin_amdgcn_s_getreg((3 << 11) | 20) & 0xFu; }
#define XB_SPIN(cond, bar) do { unsigned _sp = 0; while (cond) { __builtin_amdgcn_s_sleep(1); \
    if ((++_sp & 255u) == 0u) { if (xb_ld(&(bar)[XB_TMO])) break; if (_sp > XB_SPIN_CAP) { atomicAdd(&(bar)[XB_TMO], 1u); break; } } } } while (0)
struct XcdBarrier { unsigned* bar; unsigned x; volatile LAS unsigned* st; };
__device__ __forceinline__ XcdBarrier xcd_barrier_post(unsigned* bar, volatile LAS unsigned* st) {
    XcdBarrier b; b.bar = bar; b.x = xb_xcc_id(); b.st = st;
    if (threadIdx.x == 0) st[2] = xb_add(&bar[XB_XCNT(b.x)], 1u);
    return b;
}
__device__ __forceinline__ void xcd_barrier_complete(unsigned* bar, unsigned x, unsigned& nloc, unsigned& nx) {
    const unsigned G = gridDim.x * gridDim.y * gridDim.z;
    unsigned sum, cnt, mine, sp = 0u;
    for (;;) {
        sum = 0u; cnt = 0u; mine = 0u;
#pragma unroll
        for (unsigned j = 0; j < 16; ++j) { const unsigned c = xb_ld(&bar[XB_XCNT(j)]); sum += c; cnt += (c > 0u) ? 1u : 0u; mine = (j == x) ? c : mine; }
        if (sum == G) break;
        __builtin_amdgcn_s_sleep(1);
        if ((++sp & 255u) == 0u) { if (xb_ld(&bar[XB_TMO])) break; if (sp > XB_SPIN_CAP) { atomicAdd(&bar[XB_TMO], 1u); break; } }
    }
    nloc = mine > 0u ? mine : 1u; nx = cnt > 0u ? cnt : 1u;
}
__device__ __forceinline__ void xcd_barrier(const XcdBarrier& b) {
    asm volatile("s_waitcnt vmcnt(0)" ::: "memory");
    __syncthreads();
    if (threadIdx.x == 0) {
        unsigned* bar = b.bar;
        __builtin_amdgcn_s_waitcnt(0);
        unsigned nloc = b.st[0], nx = b.st[1];
        if (nloc == 0u) { xcd_barrier_complete(bar, b.x, nloc, nx); b.st[0] = nloc; b.st[1] = nx; }
        const unsigned old = xb_add(&bar[XB_XSUB(b.x)], 1u);
        const unsigned gen = old / nloc;
        if (old + 1u == (gen + 1u) * nloc) {
            __builtin_amdgcn_fence(__ATOMIC_RELEASE, "agent");
            asm volatile("s_waitcnt vmcnt(0)" ::: "memory");
            const unsigned og = xb_add(&bar[XB_TOP], 1u);
            const unsigned tg = og / nx;
            if (og + 1u == (tg + 1u) * nx) xb_add(&bar[XB_TOPGEN], 1u);
            else XB_SPIN(xb_ld(&bar[XB_TOPGEN]) == tg, bar);
            __builtin_amdgcn_fence(__ATOMIC_ACQUIRE, "agent");
            xb_add(&bar[XB_XGEN(b.x)], 1u);
            asm volatile("s_waitcnt vmcnt(0)" ::: "memory");
        } else {
            XB_SPIN(xb_ld(&bar[XB_XGEN(b.x)]) == gen, bar);
            __builtin_amdgcn_fence(__ATOMIC_ACQUIRE, "agent");
            asm volatile("s_waitcnt vmcnt(0)" ::: "memory");
        }
    }
    __syncthreads();
}

__device__ __forceinline__ void xcd_local_barrier(const XcdBarrier& b, unsigned nloc) {
    asm volatile("s_waitcnt vmcnt(0)" ::: "memory");
    __syncthreads();
    if (threadIdx.x == 0) {
        unsigned* bar = b.bar;
        __builtin_amdgcn_s_waitcnt(0);
        const unsigned old = xb_add(&bar[XB_LSUB(b.x)], 1u);
        const unsigned target = (old / nloc + 1u) * nloc;
        XB_SPIN(xb_ld(&bar[XB_LSUB(b.x)]) < target, bar);
        __builtin_amdgcn_fence(__ATOMIC_ACQUIRE, "agent");
        asm volatile("s_waitcnt vmcnt(0)" ::: "memory");
    }
    __syncthreads();
}
__device__ __forceinline__ void xcd_classify(const XcdBarrier& b) {
    if (threadIdx.x == 0) {
        const unsigned G = gridDim.x; unsigned cnt = 0u, dense = 0u; bool uni = (G % 8u) == 0u;
#pragma unroll
        for (unsigned j = 0; j < 16; ++j) { const unsigned c = xb_ld(&b.bar[XB_XCNT(j)]); if (c > 0u) { ++cnt; if (c != G / 8u) uni = false; if (j < b.x) ++dense; } }
        b.st[3] = (uni && cnt == 8u) ? 1u : 0u; b.st[4] = dense;
    }
    __syncthreads();
}
__global__ void __launch_bounds__(NTHR, 2) fwd_megakernel(Params P) {
    extern __shared__ __attribute__((aligned(16))) unsigned char lds_raw[];
    LAS unsigned char* lds = (LAS unsigned char*)lds_raw;
    cg::grid_group grid = cg::this_grid();
    const int tid = threadIdx.x, lane = tid & 63, wave = __builtin_amdgcn_readfirstlane(tid >> 6);
    const int G = gridDim.x, bx = blockIdx.x;
    const int vblk = (G % 8 == 0) ? (bx % 8) * (G / 8) + bx / 8 : bx;
    const int NGRP0 = (G % 8 == 0) ? 8 : 1, xg0 = bx % NGRP0, xr0 = bx / NGRP0, XR0 = G / NGRP0;
    unsigned char* ws = P.ws;
    volatile LAS unsigned* misc = (volatile LAS unsigned*)(lds + 131072);
    if (tid < 16) misc[tid] = 0u;
    __syncthreads();
    const XcdBarrier xbar = xcd_barrier_post((unsigned*)(ws + WS_BAR), misc);
    bf16_t* XB = (bf16_t*)(ws + WS_XB);
    float* SS0 = (float*)(ws + WS_SS); float* SS1 = SS0 + (size_t)M * 16; float* SS2 = SS1 + (size_t)M * 16; float* SS3 = SS2 + (size_t)M * 16; float* SS4 = SS3 + (size_t)M * 16;
    bf16_t* WIN0 = (bf16_t*)(ws + WS_WIN0); bf16_t* WOUT0 = (bf16_t*)(ws + WS_WOUT0); bf16_t* W1_0 = (bf16_t*)(ws + WS_W1_0); bf16_t* W2_0 = (bf16_t*)(ws + WS_W2_0);
    bf16_t* WIN1 = (bf16_t*)(ws + WS_WIN1); bf16_t* WOUT1 = (bf16_t*)(ws + WS_WOUT1); bf16_t* W1_1 = (bf16_t*)(ws + WS_W1_1); bf16_t* W2_1 = (bf16_t*)(ws + WS_W2_1);

    {
        LAS float* scr = (LAS float*)(lds + wave * 16384);
        const int gw = vblk * NWAVES + wave, NGW = G * NWAVES;
        constexpr int I0 = 16 * 40, I1 = 16 * 16, I2 = 16 * 64, I3 = 64 * 16, I4 = 16 * 32, I5 = 16 * 16, I6 = 16 * 64, I7 = 64 * 16;
        constexpr int NITEMS = I0 + I1 + I2 + I3 + I4 + I5 + I6 + I7;
        for (int it = gw; it < NITEMS; it += NGW) {
            int r = it;
            if (r < I0) { tr_item(P.in[2], D, NIN0, WIN0, P.in[1], 1, scr, r, lane); continue; } r -= I0;
            if (r < I1) { tr_item(P.in[8], D, D, WOUT0, nullptr, 0, scr, r, lane); continue; } r -= I1;
            if (r < I2) { tr_item(P.in[18], D, FF, W1_0, P.in[17], 0, scr, r, lane); continue; } r -= I2;
            if (r < I3) { tr_item(P.in[19], FF, D, W2_0, nullptr, 0, scr, r, lane); continue; } r -= I3;
            if (r < I4) { tr_item(P.in[10], D, NIN1, WIN1, P.in[9], 0, scr, r, lane); continue; } r -= I4;
            if (r < I5) { tr_item(P.in[16], D, D, WOUT1, nullptr, 0, scr, r, lane); continue; } r -= I5;
            if (r < I6) { tr_item(P.in[18] + (size_t)D * FF, D, FF, W1_1, P.in[17] + D, 0, scr, r, lane); continue; } r -= I6;
            tr_item(P.in[19] + (size_t)FF * D, FF, D, W2_1, nullptr, 0, scr, r, lane);
        }
        { bf16_t* WSB = (bf16_t*)(ws + WS_WSB); const float* wsrc = P.in[14];
          for (int i = vblk * NTHR + tid; i < 8 * 128 * 128 / 2; i += G * NTHR) { const int e = 2 * i, s = e & 127, t = (e >> 7) & 127; const f32x2 v = *(const f32x2*)(wsrc + e);
              ((unsigned*)WSB)[i] = cvt_pk_bf16(s <= t ? v.x : 0.f, (s + 1) <= t ? v.y : 0.f); } }
        const float* x = P.in[0];
        const int RPG = M / NGRP0, rbase = xg0 * RPG, lw = xr0 * NWAVES + wave, LW = XR0 * NWAVES;
        for (int r0 = lw; r0 < RPG; r0 += 4 * LW) {
            f32x4 v[4][4];
#pragma unroll
            for (int u = 0; u < 4; ++u) { const int row = rbase + ((r0 + u * LW < RPG) ? r0 + u * LW : r0); const f32x4* xr = (const f32x4*)(x + (size_t)row * D) + lane;
#pragma unroll
                for (int j = 0; j < 4; ++j) v[u][j] = __builtin_nontemporal_load(xr + 64 * j); }
#pragma unroll
            for (int u = 0; u < 4; ++u) { const int row = rbase + r0 + u * LW; if (r0 + u * LW < RPG) { float s = 0.f;
#pragma unroll
                for (int j = 0; j < 4; ++j) { const f32x4 t = v[u][j]; s += (t.x * t.x + t.y * t.y) + (t.z * t.z + t.w * t.w);
                    u32x2 o; o.x = cvt_pk_bf16(t.x, t.y); o.y = cvt_pk_bf16(t.z, t.w); *(u32x2*)(XB + (size_t)row * D + 4 * lane + 256 * j) = o; }
                s += __shfl_xor(s, 1); s += __shfl_xor(s, 2);
                if ((lane & 3) == 0) SS0[(size_t)row * 16 + (lane >> 2)] = s; } }
        }
    }
    if (P.ws == nullptr) grid.sync();
    xcd_barrier(xbar);
    xcd_classify(xbar);
    const bool fast = misc[3] != 0u; const unsigned nloc = misc[0];
    const int NGRP = 8, xg = fast ? (int)misc[4] : bx % NGRP, xr = fast ? (int)misc[2] : bx / NGRP, XR = G / NGRP;
    const int cg_ = fast ? xr * 8 + xg : bx;
    bf16_t* const G1w = (bf16_t*)(ws + WS_R + (size_t)xg * (20 * MiB)); bf16_t* const Uw = (bf16_t*)(ws + WS_R + (size_t)xg * (24 * MiB));
    bf16_t* const Vw = (bf16_t*)(ws + WS_R + 8 * MiB + (size_t)xg * (24 * MiB)); bf16_t* const MXw = (bf16_t*)(ws + WS_R + 16 * MiB + (size_t)xg * (24 * MiB));
#define SEAM() do { if (fast) xcd_local_barrier(xbar, nloc); else xcd_barrier(xbar); } while (0)
    const LAS float* const rs_tab = (const LAS float*)(lds + pg8::STAGE_BYTES + 256);
    { pg8::Gemm g{XB, WIN0, M, NIN0, D}; pg8::StaticOrder S; S.init(M, NIN0, G, cg_); pg8::EpiInEven E{G1w, SS0, rs_tab};
      pg8::gemm_phase<pg8::EpiInEven, pg8::StaticOrder, true, true>(lds, g, S, E); }
    SEAM();
    conv_phase(P, G1w, MXw, lds, NGRP, xg, xr, XR);
    SEAM();
    { pg8::Gemm g{MXw, WOUT0, M, D, D}; pg8::StaticOrder S; S.init(M, D, G, cg_); pg8::EpiRes E{XB, XB, SS1};
      pg8::gemm_phase<pg8::EpiRes, pg8::StaticOrder, true, true>(lds, g, S, E); }
    SEAM();
    { pg8::Gemm g{XB, W1_0, M, FF, D}; pg8::StaticOrder S; S.init(M, FF, G, cg_); pg8::EpiHid E{(bf16_t*)(ws + WS_HID), SS1, rs_tab};
      pg8::gemm_phase<pg8::EpiHid, pg8::StaticOrder, true, true>(lds, g, S, E); }
    SEAM();
    { pg8::Gemm g{(const bf16_t*)(ws + WS_HID), W2_0, M, D, FF}; pg8::StaticOrder S; S.init(M, D, G, cg_);
      pg8::EpiRes E{XB, XB, SS2};
      pg8::gemm_phase<pg8::EpiRes, pg8::StaticOrder, true, true>(lds, g, S, E); }
    SEAM();
    { pg8::Gemm g{XB, WIN1, M, NIN1, D}; pg8::StaticOrder S; S.init(M, NIN1, G, cg_);
      pg8::EpiInOdd E{Uw, Vw, SS2, P.in[11], (f32x2*)(ws + WS_VST), rs_tab};
      pg8::gemm_phase<pg8::EpiInOdd, pg8::StaticOrder, true, true>(lds, g, S, E); }
    SEAM();
    sgu_phase(P, Uw, Vw, MXw, lds, NGRP, xg, xr, XR);
    SEAM();
    { pg8::Gemm g{MXw, WOUT1, M, D, D}; pg8::StaticOrder S; S.init(M, D, G, cg_);
      pg8::EpiRes E{XB, XB, SS3};
      pg8::gemm_phase<pg8::EpiRes, pg8::StaticOrder, true, true>(lds, g, S, E); }
    SEAM();
    { pg8::Gemm g{XB, W1_1, M, FF, D}; pg8::StaticOrder S; S.init(M, FF, G, cg_); pg8::EpiHid E{(bf16_t*)(ws + WS_HID), SS3, rs_tab};
      pg8::gemm_phase<pg8::EpiHid, pg8::StaticOrder, true, true>(lds, g, S, E); }
    SEAM();
    { pg8::Gemm g{(const bf16_t*)(ws + WS_HID), W2_1, M, D, FF}; pg8::StaticOrder S; S.init(M, D, G, cg_);
      unsigned* const bw = (unsigned*)(ws + WS_BAR);
      pg8::EpiResFinal E{XB, P.out, P.in[20], (unsigned*)(ws + 60 * MiB), bw + XB_PCNT(0), bw + XB_TMO, (LAS float*)(lds + pg8::STAGE_BYTES + 256)};
      pg8::gemm_phase<pg8::EpiResFinal, pg8::StaticOrder, true, true>(lds, g, S, E); }
}

extern "C" void kernel_launch(void* const* d_in, const int* in_sizes, int n_in, void* d_out, int out_size, void* d_ws, size_t ws_size, hipStream_t stream) {
    static int grid_blocks = 0;
    if (grid_blocks == 0) {
        if (n_in != 21 || in_sizes[0] != M * D || out_size != M * D || ws_size < WS_END) { fprintf(stderr, "kernel_launch: unexpected shapes (n_in %d in0 %d out %d ws %zu)\n", n_in, n_in > 0 ? in_sizes[0] : -1, out_size, ws_size); grid_blocks = -1; return; }
        int dev = 0, cus = 0, per_cu = 0;
        (void)hipGetDevice(&dev); (void)hipDeviceGetAttribute(&cus, hipDeviceAttributeMultiprocessorCount, dev);
        if (hipFuncSetAttribute((const void*)fwd_megakernel, hipFuncAttributeMaxDynamicSharedMemorySize, LDS_BYTES) != hipSuccess) { fprintf(stderr, "kernel_launch: hipFuncSetAttribute failed\n"); grid_blocks = -1; return; }
        if (hipOccupancyMaxActiveBlocksPerMultiprocessor(&per_cu, (const void*)fwd_megakernel, NTHR, LDS_BYTES) != hipSuccess || per_cu < 1) { fprintf(stderr, "kernel_launch: occupancy query says %d\n", per_cu); per_cu = 1; }
        (void)hipGetLastError();
        if (cus % 8 != 0 || cus < 128) { fprintf(stderr, "kernel_launch: needs a CU count that is a multiple of 8 and >= 128 (got %d)\n", cus); grid_blocks = -1; return; }
        grid_blocks = cus * 1;
    }
    if (grid_blocks < 0) return;
    if (hipMemsetAsync((char*)d_ws + WS_BAR, 0, XCD_BAR_WORDS * 4, stream) != hipSuccess) { fprintf(stderr, "kernel_launch: memset of the barrier words failed\n"); return; }
    Params p{};
    for (int i = 0; i < 21; ++i) p.in[i] = (const float*)d_in[i];
    p.out = (float*)d_out; p.ws = (unsigned char*)d_ws;
    void* args[] = {&p};
    hipError_t e = hipLaunchCooperativeKernel((const void*)fwd_megakernel, dim3(grid_blocks), dim3(NTHR), args, LDS_BYTES, stream);
    if (e != hipSuccess) fprintf(stderr, "cooperative launch failed: %s (grid %d)\n", hipGetErrorString(e), grid_blocks);
}
```

```cpp
#include <hip/hip_runtime.h>
#include <hip/hip_cooperative_groups.h>
#include <cstdio>
#include <utility>
namespace cg = cooperative_groups;

#define LAS __attribute__((address_space(3)))
typedef unsigned short bf16_t;
typedef short bf16x8 __attribute__((ext_vector_type(8)));
typedef short s16x4 __attribute__((ext_vector_type(4)));
typedef float f32x4 __attribute__((ext_vector_type(4)));
typedef float f32x2 __attribute__((ext_vector_type(2)));
typedef unsigned u32x4 __attribute__((ext_vector_type(4)));
typedef unsigned u32x2 __attribute__((ext_vector_type(2)));

constexpr int D = 1024, SEQ = 2048, M = 16 * 2048, FF = 4096, NIN0 = 2560, NG1 = 1536, NIN1 = 2048;
constexpr float RMS_EPS = 1e-6f, LN_EPS = 1e-5f;
constexpr size_t MiB = 1u << 20;
constexpr size_t WS_WIN0 = 0, WS_WOUT0 = 5 * MiB, WS_W1_0 = 7 * MiB, WS_W2_0 = 15 * MiB, WS_WIN1 = 23 * MiB, WS_WOUT1 = 27 * MiB, WS_W1_1 = 29 * MiB, WS_W2_1 = 37 * MiB, WS_WSB = 45 * MiB;
constexpr size_t WS_SS = 46 * MiB  , WS_VST = 56 * MiB  , WS_XB = 64 * MiB  ;
constexpr size_t WS_R = 128 * MiB  , WS_HID = WS_R, WS_END = 384 * MiB, WS_BAR = 62 * MiB;

__device__ __forceinline__ unsigned cvt_pk_bf16(float lo, float hi) { unsigned r; asm volatile("v_cvt_pk_bf16_f32 %0, %1, %2" : "=v"(r) : "v"(lo), "v"(hi)); return r; }
__device__ __forceinline__ float bf_lo(unsigned v) { return __builtin_bit_cast(float, v << 16); }
__device__ __forceinline__ float bf_hi(unsigned v) { return __builtin_bit_cast(float, v & 0xffff0000u); }
__device__ __forceinline__ float relu1(float x) { float r; asm("v_max_f32_e32 %0, 0, %1" : "=v"(r) : "v"(x)); return r; }
__device__ __forceinline__ float fast_sigmoid(float x) { return __builtin_amdgcn_rcpf(1.0f + __builtin_amdgcn_exp2f(x * -1.44269504089f)); }

namespace pg8 {
constexpr int BM = 256, BK = 64, HALF = 128, HTB = HALF * BK * 2, STAGE_BYTES = 8 * HTB, NXCD = 8, WGM = 8;
__host__ __device__ __forceinline__ int lds_byte(int r, int c) { const int st = (r >> 4) * 2 + (c >> 5), rr = r & 15, cc = c & 31, ob = rr * 64 + cc * 2; return st * 1024 + (ob ^ (((ob >> 9) & 1) << 5)); }
__host__ __device__ __forceinline__ void stage_rc(int b, int& R, int& C) { const int st = b / 1024, sb = b % 1024, swz = sb ^ (((sb >> 9) & 1) << 5); R = (st >> 1) * 16 + swz / 64; C = (st & 1) * 32 + (swz % 64) / 2; }
__host__ __device__ __forceinline__ int perm32(int rho) { const int n = rho >> 4, i = rho & 15; return 8 * (i >> 2) + 4 * n + (i & 3); }
struct Unit { int pm, pn; };
struct Gemm { const bf16_t* A; const bf16_t* Bt; int M, N, K; };
struct StaticOrder {
    int nM, nN, nwg, G, c;
    __device__ void init(int M_, int N_, int G_, int c_) { nM = M_ / BM; nN = N_ / BM; nwg = nM * nN; G = G_; c = c_; }
    __device__ bool next(int i, Unit& u) const {
        const long L = (long)i * G + c; if (L >= nwg) return false;
        int wgid = (int)L; { const int q = nwg / NXCD, r = nwg % NXCD, xcd = wgid % NXCD, off = wgid / NXCD; wgid = (xcd < r ? xcd * (q + 1) : r * (q + 1) + (xcd - r) * q) + off; }
        const int nig = WGM * nN, gid = wgid / nig, fm = gid * WGM, gsz = (nM - fm) < WGM ? (nM - fm) : WGM;
        u.pm = fm + ((wgid % nig) % gsz); u.pn = (wgid % nig) / gsz; return true;
    }
};
__device__ __forceinline__ f32x2 gelu_pk(f32x2 v) {
    const f32x2 av = __builtin_elementwise_abs(v), d = av * 0.2316418882f + 1.0f;
    f32x2 t; t.x = __builtin_amdgcn_rcpf(d.x); t.y = __builtin_amdgcn_rcpf(d.y);
    f32x2 q = t * 0.5307027145f + (-0.7265760135f); q = q * t + 0.7107068705f; q = q * t + (-0.142248368f); q = q * t + 0.127414796f; q = q * t;
    const f32x2 s = (v * v) * (-0.72134752044f);
    f32x2 e; e.x = __builtin_amdgcn_exp2f(s.x); e.y = __builtin_amdgcn_exp2f(s.y);
    const f32x2 m = v * (q * e), r = v - m;
    f32x2 o; o.x = v.x < 0.f ? m.x : r.x; o.y = v.y < 0.f ? m.y : r.y; return o;
}
__device__ __forceinline__ float row_rs(const float* ss, int row) {
    const f32x4* p = (const f32x4*)(ss + (size_t)row * 16); f32x4 a = p[0], b = p[1], c = p[2], d = p[3]; a = (a + b) + (c + d);
    return __builtin_amdgcn_rsqf(((a.x + a.y) + (a.z + a.w)) * (1.0f / 1024.0f) + RMS_EPS);
}

struct EpiInEven {
    static constexpr bool PERM = true, AFTER_DRAIN = false;
    static constexpr bool NEEDS_RS = true;
    bf16_t* G1; const float* ss; const LAS float* rs_tab;
    __device__ __forceinline__ void operator()(const f32x4 (&acc)[2][2][4][2], const Unit& u, int ui, int wr, int wc, int fr, int fq) const {
        const LAS float* rsp = rs_tab + ui * 256 + wr * 64 + fr; float rsv[2][4];
#pragma unroll
        for (int ai = 0; ai < 2; ++ai)
#pragma unroll
            for (int m = 0; m < 4; ++m) rsv[ai][m] = rsp[ai * HALF + m * 16];
        const int row0 = u.pm * BM + wr * 64 + fr;
#pragma unroll
        for (int ai = 0; ai < 2; ++ai)
#pragma unroll
            for (int m = 0; m < 4; ++m) {
                const int row = row0 + ai * HALF + m * 16; const float r = rsv[ai][m];
                bf16_t* rowp = G1 + (size_t)row * NG1 + wc * 32 + 8 * fq;
                if (u.pn < 4) {
                    f32x4 v0 = acc[ai][0][m][0] * r, v1 = acc[ai][0][m][1] * r, g0 = acc[ai][1][m][0] * r, g1 = acc[ai][1][m][1] * r;
#pragma unroll
                    for (int j = 0; j < 4; ++j) { v0[j] *= fast_sigmoid(g0[j]); v1[j] *= fast_sigmoid(g1[j]); }
                    u32x4 w; w.x = cvt_pk_bf16(v0[0], v0[1]); w.y = cvt_pk_bf16(v0[2], v0[3]); w.z = cvt_pk_bf16(v1[0], v1[1]); w.w = cvt_pk_bf16(v1[2], v1[3]);
                    *(u32x4*)(rowp + 128 * u.pn) = w;
                } else if (u.pn < 8) {
                    const float r2 = r * r; f32x4 v0 = acc[ai][0][m][0] * acc[ai][1][m][0] * r2, v1 = acc[ai][0][m][1] * acc[ai][1][m][1] * r2;
                    u32x4 w; w.x = cvt_pk_bf16(v0[0], v0[1]); w.y = cvt_pk_bf16(v0[2], v0[3]); w.z = cvt_pk_bf16(v1[0], v1[1]); w.w = cvt_pk_bf16(v1[2], v1[3]);
                    *(u32x4*)(rowp + 512 + 128 * (u.pn - 4)) = w;
                } else {
#pragma unroll
                    for (int bj = 0; bj < 2; ++bj) { f32x4 v0 = acc[ai][bj][m][0] * r, v1 = acc[ai][bj][m][1] * r;
                        u32x4 w; w.x = cvt_pk_bf16(v0[0], v0[1]); w.y = cvt_pk_bf16(v0[2], v0[3]); w.z = cvt_pk_bf16(v1[0], v1[1]); w.w = cvt_pk_bf16(v1[2], v1[3]);
                        *(u32x4*)(rowp + 1024 + 256 * (u.pn - 8) + 128 * bj) = w; }
                }
            }
    }
};
struct EpiRes {
    static constexpr bool PERM = true, AFTER_DRAIN = false;
    static constexpr bool NEEDS_RS = false;
    const bf16_t* res; bf16_t* XB; float* ssout;
    __device__ __forceinline__ void operator()(const f32x4 (&acc)[2][2][4][2], const Unit& u, int ui, int wr, int wc, int fr, int fq) const {
        const int row0 = u.pm * BM + wr * 64 + fr, col0 = u.pn * BM + wc * 32 + 8 * fq;
        u32x4 rv[2][4][2];
#pragma unroll
        for (int ai = 0; ai < 2; ++ai)
#pragma unroll
            for (int m = 0; m < 4; ++m)
#pragma unroll
                for (int bj = 0; bj < 2; ++bj) rv[ai][m][bj] = *(const u32x4*)(res + (size_t)(row0 + ai * HALF + m * 16) * D + col0 + bj * HALF);
#pragma unroll
        for (int ai = 0; ai < 2; ++ai) {
#pragma unroll
            for (int m = 0; m < 4; ++m) {
                const int row = row0 + ai * HALF + m * 16; const size_t off = (size_t)row * D + col0; float q = 0.f;
#pragma unroll
                for (int bj = 0; bj < 2; ++bj) {
                    const u32x4 r = rv[ai][m][bj];
                    const f32x4 h0 = (f32x4){bf_lo(r.x), bf_hi(r.x), bf_lo(r.y), bf_hi(r.y)} + acc[ai][bj][m][0], h1 = (f32x4){bf_lo(r.z), bf_hi(r.z), bf_lo(r.w), bf_hi(r.w)} + acc[ai][bj][m][1];
                    q += (h0[0] * h0[0] + h0[1] * h0[1]) + (h0[2] * h0[2] + h0[3] * h0[3]) + (h1[0] * h1[0] + h1[1] * h1[1]) + (h1[2] * h1[2] + h1[3] * h1[3]);
                    u32x4 w; w.x = cvt_pk_bf16(h0[0], h0[1]); w.y = cvt_pk_bf16(h0[2], h0[3]); w.z = cvt_pk_bf16(h1[0], h1[1]); w.w = cvt_pk_bf16(h1[2], h1[3]);
                    *(u32x4*)(XB + off + bj * HALF) = w;
                }
                q += __shfl_xor(q, 16); q += __shfl_xor(q, 32);
                if (fq == 0) ssout[(size_t)row * 16 + u.pn * 4 + wc] = q;
            }
            asm volatile("" ::: "memory");
        }
    }
};
struct EpiResFinal {
    static constexpr bool PERM = true, AFTER_DRAIN = false, NEEDS_RS = false;
    const bf16_t* res; float* out; const float* gfin; unsigned* xq; unsigned* cnt; unsigned* tmo; LAS float* sl;
    __device__ __forceinline__ void operator()(f32x4 (&acc)[2][2][4][2], const Unit& u, int ui, int wr, int wc, int fr, int fq) const {
        const int row0 = u.pm * BM + wr * 64 + fr, col0 = u.pn * BM + wc * 32 + 8 * fq, tid = threadIdx.x;
        LAS float* part = sl; LAS float* rsT = sl + 1024;
#pragma unroll
        for (int ai = 0; ai < 2; ++ai) {
            u32x4 rv[4][2];
#pragma unroll
            for (int m = 0; m < 4; ++m)
#pragma unroll
                for (int bj = 0; bj < 2; ++bj) rv[m][bj] = *(const u32x4*)(res + (size_t)(row0 + ai * HALF + m * 16) * D + col0 + bj * HALF);
#pragma unroll
            for (int m = 0; m < 4; ++m) { float q = 0.f;
#pragma unroll
                for (int bj = 0; bj < 2; ++bj) { const u32x4 r = rv[m][bj];
                    const f32x4 h0 = (f32x4){bf_lo(r.x), bf_hi(r.x), bf_lo(r.y), bf_hi(r.y)} + acc[ai][bj][m][0], h1 = (f32x4){bf_lo(r.z), bf_hi(r.z), bf_lo(r.w), bf_hi(r.w)} + acc[ai][bj][m][1];
                    q += (h0[0] * h0[0] + h0[1] * h0[1]) + (h0[2] * h0[2] + h0[3] * h0[3]) + (h1[0] * h1[0] + h1[1] * h1[1]) + (h1[2] * h1[2] + h1[3] * h1[3]);
                    acc[ai][bj][m][0] = h0; acc[ai][bj][m][1] = h1; }
                q += __shfl_xor(q, 16); q += __shfl_xor(q, 32);
                if (fq == 0) part[(ai * HALF + wr * 64 + m * 16 + fr) * 4 + wc] = q; }
        }
        asm volatile("s_waitcnt lgkmcnt(0)" ::: "memory"); __builtin_amdgcn_s_barrier(); asm volatile("" ::: "memory");
        if (tid < 256) { const f32x4 p = *(const LAS f32x4*)(part + tid * 4);
            __hip_atomic_store(xq + (size_t)(u.pm * BM + tid) * 4 + u.pn, __builtin_bit_cast(unsigned, (p.x + p.y) + (p.z + p.w)), __ATOMIC_RELAXED, __HIP_MEMORY_SCOPE_AGENT); }
        asm volatile("s_waitcnt vmcnt(0)" ::: "memory"); __builtin_amdgcn_s_barrier(); asm volatile("" ::: "memory");
        if (tid == 0) { unsigned* c = cnt + 16 * u.pm; __hip_atomic_fetch_add(c, 1u, __ATOMIC_RELAXED, __HIP_MEMORY_SCOPE_AGENT);
            unsigned sp = 0u;
            while (__hip_atomic_load(c, __ATOMIC_RELAXED, __HIP_MEMORY_SCOPE_AGENT) < 4u) { __builtin_amdgcn_s_sleep(1);
                if ((++sp & 255u) == 0u) { if (__hip_atomic_load(tmo, __ATOMIC_RELAXED, __HIP_MEMORY_SCOPE_AGENT)) break; if (sp > (1u << 18)) { atomicAdd(tmo, 1u); break; } } }
            __builtin_amdgcn_fence(__ATOMIC_ACQUIRE, "agent"); asm volatile("s_waitcnt vmcnt(0)" ::: "memory"); }
        __builtin_amdgcn_s_barrier(); asm volatile("" ::: "memory");
        if (tid < 256) { const unsigned* p = xq + (size_t)(u.pm * BM + tid) * 4; float sm = 0.f;
#pragma unroll
            for (int t = 0; t < 4; ++t) sm += __builtin_bit_cast(float, __hip_atomic_load(p + t, __ATOMIC_RELAXED, __HIP_MEMORY_SCOPE_AGENT));
            rsT[tid] = __builtin_amdgcn_rsqf(sm * (1.0f / 1024.0f) + RMS_EPS); }
        asm volatile("s_waitcnt lgkmcnt(0)" ::: "memory"); __builtin_amdgcn_s_barrier(); asm volatile("" ::: "memory");
        f32x4 gv[2][2];
#pragma unroll
        for (int bj = 0; bj < 2; ++bj)
#pragma unroll
            for (int n = 0; n < 2; ++n) gv[bj][n] = *(const f32x4*)(gfin + col0 + bj * HALF + 4 * n);
#pragma unroll
        for (int ai = 0; ai < 2; ++ai)
#pragma unroll
            for (int m = 0; m < 4; ++m) { const int rl = ai * HALF + wr * 64 + m * 16 + fr; const float r = rsT[rl]; float* orow = out + (size_t)(u.pm * BM + rl) * D + col0;
#pragma unroll
                for (int bj = 0; bj < 2; ++bj)
#pragma unroll
                    for (int n = 0; n < 2; ++n) *(f32x4*)(orow + bj * HALF + 4 * n) = acc[ai][bj][m][n] * r * gv[bj][n]; }
    }
};
struct EpiHid {
    static constexpr bool PERM = true, AFTER_DRAIN = false;
    static constexpr bool NEEDS_RS = true;
    bf16_t* O; const float* ss; const LAS float* rs_tab;
    __device__ __forceinline__ void operator()(const f32x4 (&acc)[2][2][4][2], const Unit& u, int ui, int wr, int wc, int fr, int fq) const {
        const LAS float* rsp = rs_tab + ui * 256 + wr * 64 + fr; float rsv[2][4];
#pragma unroll
        for (int ai = 0; ai < 2; ++ai)
#pragma unroll
            for (int m = 0; m < 4; ++m) rsv[ai][m] = rsp[ai * HALF + m * 16];
        const int row0 = u.pm * BM + wr * 64 + fr, col0 = u.pn * BM + wc * 32 + 8 * fq;
#pragma unroll
        for (int ai = 0; ai < 2; ++ai)
#pragma unroll
            for (int m = 0; m < 4; ++m) {
                const int row = row0 + ai * HALF + m * 16; const float r = rsv[ai][m], r2 = r * r;
                bf16_t* rowp = O + (size_t)row * FF + col0;
#pragma unroll
                for (int bj = 0; bj < 2; ++bj) {
                    f32x4 v0, v1;
#pragma unroll
                    for (int j = 0; j < 4; ++j) { v0[j] = relu1(acc[ai][bj][m][0][j]); v1[j] = relu1(acc[ai][bj][m][1][j]); }
                    v0 = v0 * v0 * r2; v1 = v1 * v1 * r2;
                    u32x4 w; w.x = cvt_pk_bf16(v0[0], v0[1]); w.y = cvt_pk_bf16(v0[2], v0[3]); w.z = cvt_pk_bf16(v1[0], v1[1]); w.w = cvt_pk_bf16(v1[2], v1[3]);
                    __builtin_nontemporal_store(w, (u32x4*)(rowp + bj * HALF)); }
            }
    }
};
struct EpiInOdd {
    static constexpr bool PERM = true, AFTER_DRAIN = false;
    static constexpr bool NEEDS_RS = true;
    bf16_t* U; bf16_t* V; const float* ss; const float* bias; f32x2* vst; const LAS float* rs_tab;
    __device__ __forceinline__ void operator()(const f32x4 (&acc)[2][2][4][2], const Unit& u, int ui, int wr, int wc, int fr, int fq) const {
        const LAS float* rsp = rs_tab + ui * 256 + wr * 64 + fr; float rsv[2][4];
#pragma unroll
        for (int ai = 0; ai < 2; ++ai)
#pragma unroll
            for (int m = 0; m < 4; ++m) rsv[ai][m] = rsp[ai * HALF + m * 16];
        const int row0 = u.pm * BM + wr * 64 + fr, colt = wc * 32 + 8 * fq; const bool isv = u.pn >= 4;
        bf16_t* base = isv ? V : U; const int col0 = (isv ? u.pn - 4 : u.pn) * BM + colt;
        f32x4 bv[2][2];
#pragma unroll
        for (int bj = 0; bj < 2; ++bj)
#pragma unroll
            for (int n = 0; n < 2; ++n) bv[bj][n] = *(const f32x4*)(bias + u.pn * BM + colt + bj * HALF + 4 * n);
#pragma unroll
        for (int ai = 0; ai < 2; ++ai)
#pragma unroll
            for (int m = 0; m < 4; ++m) {
                const int row = row0 + ai * HALF + m * 16; const float r = rsv[ai][m]; float s = 0.f, q = 0.f;
                bf16_t* rowp = base + (size_t)row * D + col0;
#pragma unroll
                for (int bj = 0; bj < 2; ++bj) {
                    f32x4 v0 = acc[ai][bj][m][0] * r + bv[bj][0], v1 = acc[ai][bj][m][1] * r + bv[bj][1];
                    f32x2 a = gelu_pk((f32x2){v0[0], v0[1]}), b = gelu_pk((f32x2){v0[2], v0[3]}), c = gelu_pk((f32x2){v1[0], v1[1]}), d = gelu_pk((f32x2){v1[2], v1[3]});
                    s += (a.x + a.y) + (b.x + b.y) + (c.x + c.y) + (d.x + d.y);
                    q += (a.x * a.x + a.y * a.y) + (b.x * b.x + b.y * b.y) + (c.x * c.x + c.y * c.y) + (d.x * d.x + d.y * d.y);
                    u32x4 w; w.x = cvt_pk_bf16(a.x, a.y); w.y = cvt_pk_bf16(b.x, b.y); w.z = cvt_pk_bf16(c.x, c.y); w.w = cvt_pk_bf16(d.x, d.y);
                    *(u32x4*)(rowp + bj * HALF) = w; }
                if (isv) { s += __shfl_xor(s, 16); s += __shfl_xor(s, 32); q += __shfl_xor(q, 16); q += __shfl_xor(q, 32);
                    if (fq == 0) vst[(size_t)row * 16 + (u.pn - 4) * 4 + wc] = (f32x2){s, q}; }
            }
    }
};

template <class Epi, class Sched, bool ALIGN_EPI = false, bool SP2 = false>
__device__ __forceinline__ void gemm_phase(LAS unsigned char* lds, const Gemm g, const Sched& S, const Epi& E) {
    int tid_ = threadIdx.x; asm volatile("" : "+v"(tid_));
    const int tid = tid_, wid = __builtin_amdgcn_readfirstlane(tid >> 6), lane = tid & 63, wr = wid >> 2, wc = wid & 3, fr = lane & 15, fq = lane >> 4;
    const int K = g.K, nt = K / BK;
    unsigned voffA[2], voffB[2];
#pragma unroll
    for (int i = 0; i < 2; ++i) { int R, C; stage_rc(tid * 16 + i * 8192, R, C); const int Rb = Epi::PERM ? ((R & ~31) + perm32(R & 31)) : R;
        voffA[i] = (unsigned)(R * K + C) * 2u; voffB[i] = (unsigned)(Rb * K + C) * 2u; }
    const size_t kstep = (size_t)(BK * 2);
    const size_t hstep = (size_t)HALF * K * 2;
    const size_t tstep = 2 * hstep;
    const unsigned ldsw = (unsigned)wid * 1024u;
    const int aoff = lds_byte(wr * 64 + fr, fq * 8), boff = lds_byte(wc * 32 + fr, fq * 8);
#define PG8_SA(b, h) (((b) * 2 + (h)) * HTB)
#define PG8_SB(b, h) ((4 + (b) * 2 + (h)) * HTB)
#define PG8_STAGE(bufoff, gbase, voff) do { _Pragma("unroll") for (int _i = 0; _i < 2; ++_i) \
        __builtin_amdgcn_global_load_lds((const unsigned*)((const char*)(gbase) + (voff)[_i]), (LAS unsigned*)(lds + (bufoff) + ldsw + _i * 8192), 16, 0, 0); } while (0)
#define PG8_LDA(dst, b, h) do { _Pragma("unroll") for (int m = 0; m < 4; ++m) _Pragma("unroll") for (int k = 0; k < 2; ++k) dst[m][k] = *(const LAS bf16x8*)(lds + PG8_SA(b, h) + aoff + m * 2048 + k * 1024); } while (0)
#define PG8_LDB(dst, b, h) do { _Pragma("unroll") for (int n = 0; n < 2; ++n) _Pragma("unroll") for (int k = 0; k < 2; ++k) dst[n][k] = *(const LAS bf16x8*)(lds + PG8_SB(b, h) + boff + n * 2048 + k * 1024); } while (0)
#define PG8_MMA(ai, bj, At, Bt) do { __builtin_amdgcn_s_setprio(1); _Pragma("unroll") for (int m = 0; m < 4; ++m) _Pragma("unroll") for (int n = 0; n < 2; ++n) _Pragma("unroll") for (int k = 0; k < 2; ++k) \
        acc[ai][bj][m][n] = __builtin_amdgcn_mfma_f32_16x16x32_bf16(Bt[n][k], At[m][k], acc[ai][bj][m][n], 0, 0, 0); __builtin_amdgcn_s_setprio(0); } while (0)
#define PG8_WAIT_V(n) asm volatile("s_waitcnt vmcnt(" #n ")" ::: "memory")
#define PG8_WAIT_L(n) asm volatile("s_waitcnt lgkmcnt(" #n ")" ::: "memory")
#define PG8_BAR __builtin_amdgcn_s_barrier()
#define PG8_SCHED __builtin_amdgcn_sched_barrier(0)
    Unit cur, nxt; int ui = 0;
    if (!S.next(0, cur)) return;
    f32x4 acc[2][2][4][2];
#pragma unroll
    for (int a = 0; a < 2; ++a)
#pragma unroll
        for (int b = 0; b < 2; ++b)
#pragma unroll
            for (int m = 0; m < 4; ++m)
#pragma unroll
                for (int n = 0; n < 2; ++n) acc[a][b][m][n] = (f32x4){0.f, 0.f, 0.f, 0.f};
    bf16x8 At[4][2], B0[2][2], B1[2][2];
    const char* cA = (const char*)g.A + (size_t)cur.pm * tstep; const char* cB = (const char*)g.Bt + (size_t)cur.pn * tstep;
    if constexpr (SP2) {
        PG8_STAGE(PG8_SB(0, 0), cB, voffB); PG8_STAGE(PG8_SB(0, 1), cB + hstep, voffB); PG8_STAGE(PG8_SA(0, 0), cA, voffA); PG8_STAGE(PG8_SA(0, 1), cA + hstep, voffA);
        if constexpr (Epi::NEEDS_RS) {
            LAS float* tab = (LAS float*)(lds + STAGE_BYTES + 256); Unit pu;
            for (int i = tid >> 8; S.next(i, pu); i += 2) tab[i * 256 + (tid & 255)] = row_rs(E.ss, pu.pm * BM + (tid & 255));
            PG8_WAIT_L(0);
        }
        if (wr == 1) PG8_BAR;
        PG8_WAIT_V(2); PG8_BAR;
        PG8_STAGE(PG8_SB(1, 0), cB + kstep, voffB); PG8_STAGE(PG8_SA(1, 0), cA + kstep, voffA); PG8_STAGE(PG8_SB(1, 1), cB + hstep + kstep, voffB);
        PG8_WAIT_V(6); PG8_BAR;
    } else {
        PG8_STAGE(PG8_SB(0, 0), cB, voffB); PG8_STAGE(PG8_SA(0, 0), cA, voffA); PG8_STAGE(PG8_SB(0, 1), cB + hstep, voffB); PG8_STAGE(PG8_SA(0, 1), cA + hstep, voffA);
        if (wr == 1) PG8_BAR;
        PG8_WAIT_V(4); PG8_BAR;
        PG8_STAGE(PG8_SB(1, 0), cB + kstep, voffB); PG8_STAGE(PG8_SA(1, 0), cA + kstep, voffA); PG8_STAGE(PG8_SB(1, 1), cB + hstep + kstep, voffB);
        PG8_WAIT_V(6); PG8_BAR;
    }
    for (;;) {
        const bool has_next = S.next(ui + 1, nxt);
        const char* nA = has_next ? (const char*)g.A + (size_t)nxt.pm * tstep : cA; const char* nB = has_next ? (const char*)g.Bt + (size_t)nxt.pn * tstep : cB;
        for (int t = 0; t < nt; t += 2) {
            const bool last = (t == nt - 2);
            const char* a1 = cA + (size_t)(t + 1) * kstep;
            const char* a2 = last ? nA : cA + (size_t)(t + 2) * kstep; const char* b2 = last ? nB : cB + (size_t)(t + 2) * kstep;
            const char* a3 = a2 + kstep; const char* b3 = b2 + kstep;
            if constexpr (SP2) {
            PG8_LDB(B0, 0, 0); PG8_LDB(B1, 0, 1); PG8_SCHED; PG8_LDA(At, 0, 0); PG8_STAGE(PG8_SA(1, 1), a1 + hstep, voffA);
            PG8_WAIT_V(8); PG8_WAIT_L(0); PG8_BAR; PG8_MMA(0, 0, At, B0); PG8_MMA(0, 1, At, B1); PG8_BAR; PG8_SCHED;
            PG8_LDA(At, 0, 1); PG8_STAGE(PG8_SB(0, 0), b2, voffB); PG8_STAGE(PG8_SB(0, 1), b2 + hstep, voffB); PG8_STAGE(PG8_SA(0, 0), a2, voffA);
            PG8_WAIT_V(8); PG8_WAIT_L(0); PG8_BAR; PG8_MMA(1, 0, At, B0); PG8_MMA(1, 1, At, B1); PG8_BAR; PG8_SCHED;
            PG8_LDB(B0, 1, 0); PG8_LDB(B1, 1, 1); PG8_SCHED; PG8_LDA(At, 1, 0); PG8_STAGE(PG8_SA(0, 1), a2 + hstep, voffA);
            PG8_WAIT_V(8); PG8_WAIT_L(0); PG8_BAR; PG8_MMA(0, 0, At, B0); PG8_MMA(0, 1, At, B1); PG8_BAR; PG8_SCHED;
            PG8_LDA(At, 1, 1); PG8_STAGE(PG8_SB(1, 0), b3, voffB); PG8_STAGE(PG8_SB(1, 1), b3 + hstep, voffB); PG8_STAGE(PG8_SA(1, 0), a3, voffA);
            PG8_WAIT_V(8); PG8_WAIT_L(0); PG8_BAR; PG8_MMA(1, 0, At, B0); PG8_MMA(1, 1, At, B1); PG8_BAR; PG8_SCHED;
            } else {
            PG8_LDB(B0, 0, 0); PG8_SCHED; PG8_LDA(At, 0, 0); PG8_STAGE(PG8_SA(1, 1), a1 + hstep, voffA);
            PG8_WAIT_L(8); PG8_BAR; PG8_WAIT_L(0); PG8_MMA(0, 0, At, B0); PG8_BAR; PG8_SCHED;
            PG8_LDB(B1, 0, 1); PG8_STAGE(PG8_SB(0, 0), b2, voffB);
            PG8_BAR; PG8_WAIT_L(0); PG8_MMA(0, 1, At, B1); PG8_BAR;
            PG8_LDA(At, 0, 1); PG8_STAGE(PG8_SA(0, 0), a2, voffA);
            PG8_BAR; PG8_WAIT_L(0); PG8_MMA(1, 0, At, B0); PG8_BAR; PG8_SCHED;
            PG8_STAGE(PG8_SB(0, 1), b2 + hstep, voffB);
            PG8_WAIT_V(6); PG8_BAR; PG8_MMA(1, 1, At, B1); PG8_BAR;
            PG8_LDB(B0, 1, 0); PG8_SCHED; PG8_LDA(At, 1, 0); PG8_STAGE(PG8_SA(0, 1), a2 + hstep, voffA);
            PG8_WAIT_L(8); PG8_BAR; PG8_WAIT_L(0); PG8_MMA(0, 0, At, B0); PG8_BAR; PG8_SCHED;
            PG8_LDB(B1, 1, 1); PG8_STAGE(PG8_SB(1, 0), b3, voffB);
            PG8_BAR; PG8_WAIT_L(0); PG8_MMA(0, 1, At, B1); PG8_BAR;
            PG8_LDA(At, 1, 1); PG8_STAGE(PG8_SA(1, 0), a3, voffA);
            PG8_BAR; PG8_WAIT_L(0); PG8_MMA(1, 0, At, B0); PG8_BAR; PG8_SCHED;
            PG8_STAGE(PG8_SB(1, 1), b3 + hstep, voffB);
            PG8_WAIT_V(6); PG8_BAR; PG8_MMA(1, 1, At, B1); PG8_BAR;
            }
        }
        if constexpr (ALIGN_EPI) { if (wr == 0) PG8_BAR; }
        E(acc, cur, ui, wr, wc, fr, fq);
        if (!has_next) break;
#pragma unroll
        for (int a = 0; a < 2; ++a)
#pragma unroll
            for (int b = 0; b < 2; ++b)
#pragma unroll
                for (int m = 0; m < 4; ++m)
#pragma unroll
                    for (int n = 0; n < 2; ++n) acc[a][b][m][n] = (f32x4){0.f, 0.f, 0.f, 0.f};
        cur = nxt; cA = nA; cB = nB; ++ui;
        if constexpr (ALIGN_EPI) { if (wr == 1) PG8_BAR; }
    }
    PG8_WAIT_V(0);
    if constexpr (!ALIGN_EPI) { if (wr == 0) PG8_BAR; }
    PG8_BAR;
#undef PG8_SA
#undef PG8_SB
#undef PG8_STAGE
#undef PG8_LDA
#undef PG8_LDB
#undef PG8_MMA
#undef PG8_WAIT_V
#undef PG8_WAIT_L
#undef PG8_BAR
#undef PG8_SCHED
}
}

constexpr int NWAVES = 8, NTHR = 512;
constexpr int LDS_BYTES = 131072 + 256 + 16 * 1024;
#define LDS_WAIT() asm volatile("s_waitcnt lgkmcnt(0)" ::: "memory")

__device__ __forceinline__ void tr_item(const float* W, int K, int N, bf16_t* WT, const float* gain, int mode, LAS float* scr, int item, int lane) {
    const int nblk = N / 64, kb = item / nblk, nb = item % nblk, k0 = 64 * kb, n0 = 64 * nb;
    int ns = n0;
    if (mode) { const int t = n0 >> 8, j = n0 & 255;
        if (t < 4) ns = (j < 128) ? 128 * t + j : 512 + 128 * t + (j - 128);
        else if (t < 8) ns = (j < 128) ? 1536 + 128 * (t - 4) + j : 2048 + 128 * (t - 4) + (j - 128);
        else ns = 1024 + 256 * (t - 8) + j; }
    const int r4 = lane >> 4, c4 = (lane & 15) * 4;
    f32x4 v[16];
#pragma unroll
    for (int i = 0; i < 16; ++i) v[i] = __builtin_nontemporal_load((const f32x4*)(W + (size_t)(k0 + 4 * i + r4) * N + ns + c4));
    if (gain) {
#pragma unroll
        for (int i = 0; i < 16; ++i) v[i] = v[i] * gain[k0 + 4 * i + r4];
    }
    const int c = lane & 7;
#pragma unroll
    for (int h = 0; h < 2; ++h) {
        if (((lane & 15) >> 3) == h) { const int cc = c4 - 32 * h;
#pragma unroll
            for (int i = 0; i < 16; ++i) { LAS float* d = scr + (4 * i + r4) * 33 + cc; d[0] = v[i][0]; d[1] = v[i][1]; d[2] = v[i][2]; d[3] = v[i][3]; } }
        LDS_WAIT(); asm volatile("" ::: "memory");
#pragma unroll
        for (int j = 0; j < 4; ++j) { const int n = (lane >> 3) + 8 * j; const LAS float* sp = scr + (8 * c) * 33 + n;
            u32x4 o; o.x = cvt_pk_bf16(sp[0 * 33], sp[1 * 33]); o.y = cvt_pk_bf16(sp[2 * 33], sp[3 * 33]); o.z = cvt_pk_bf16(sp[4 * 33], sp[5 * 33]); o.w = cvt_pk_bf16(sp[6 * 33], sp[7 * 33]);
            *(u32x4*)(WT + (size_t)(n0 + 32 * h + n) * K + k0 + 8 * c) = o; }
        LDS_WAIT(); asm volatile("" ::: "memory");
    }
}

struct Params { const float* in[21]; float* out; unsigned char* ws; };

constexpr int CR = 16;
template <int J, int I> __device__ __forceinline__ void conv_tap(f32x2 (&acc)[CR], const f32x2 (&w)[31], f32x2 x) {
    if constexpr (J - I >= 0 && J - I <= 30) acc[I] += w[J - I] * x;
}
template <int J, int... I> __device__ __forceinline__ void conv_row(f32x2 (&acc)[CR], const f32x2 (&w)[31], f32x2 x, std::integer_sequence<int, I...>) { (conv_tap<J, I>(acc, w, x), ...); }
template <int J> __device__ __forceinline__ void conv_j(f32x2 (&acc)[CR], const f32x2 (&w)[31], const unsigned (&xw)[CR + 30]) {
    const unsigned xv = xw[J];
    conv_row<J>(acc, w, (f32x2){bf_lo(xv), bf_hi(xv)}, std::make_integer_sequence<int, CR>{});
}
template <int... J> __device__ __forceinline__ void conv_all(f32x2 (&acc)[CR], const f32x2 (&w)[31], const unsigned (&xw)[CR + 30], std::integer_sequence<int, J...>) { (conv_j<J>(acc, w, xw), ...); }
template <int OFF, int... J> __device__ __forceinline__ void conv_load(unsigned (&xw)[CR + 30], const bf16_t* src, int tl, std::integer_sequence<int, J...>) {
    ((xw[OFF + J] = (tl - 30 + OFF + J >= 0) ? *(const unsigned*)(src + (size_t)(OFF + J) * NG1) : 0u), ...);
}
constexpr int CV_EARLY = 24;
__device__ __forceinline__ float xreduce16(const float (&v)[16], int lane) {
    float b[8], c[4], d[2], e;
    { const bool up = lane & 32;
#pragma unroll
      for (int i = 0; i < 8; ++i) { const float keep = up ? v[i + 8] : v[i], send = up ? v[i] : v[i + 8]; b[i] = keep + __shfl_xor(send, 32); } }
    { const bool up = lane & 16;
#pragma unroll
      for (int i = 0; i < 4; ++i) { const float keep = up ? b[i + 4] : b[i], send = up ? b[i] : b[i + 4]; c[i] = keep + __shfl_xor(send, 16); } }
    { const bool up = lane & 8;
#pragma unroll
      for (int i = 0; i < 2; ++i) { const float keep = up ? c[i + 2] : c[i], send = up ? c[i] : c[i + 2]; d[i] = keep + __shfl_xor(send, 8); } }
    { const bool up = lane & 4; const float keep = up ? d[1] : d[0], send = up ? d[0] : d[1]; e = keep + __shfl_xor(send, 4); }
    e += __shfl_xor(e, 2); e += __shfl_xor(e, 1);
    return e;
}

__device__ __forceinline__ void conv_phase(const Params& P, const bf16_t* G1, bf16_t* MX, LAS unsigned char* lds, int NGRP, int xg, int xr, int XR) {
    const float* caw = P.in[3]; const float* cab = P.in[4]; const float* lng = P.in[5]; const float* lnb = P.in[6]; const float* cbw = P.in[7];
    int tid_ = threadIdx.x; asm volatile("" : "+v"(tid_));
    const int tid = tid_, grp = tid >> 8, t8 = tid & 255, lane = tid & 63, wv = (tid >> 6) & 3;
    const int c0 = 2 * t8;
    LAS float* red = (LAS float*)lds;
    LAS float* st = (LAS float*)(lds + 4096);
    f32x2 w[31];
#pragma unroll
    for (int k = 0; k < 31; ++k) w[k] = *(const f32x2*)(caw + k * 512 + c0);
    const f32x2 cb = *(const f32x2*)(cab + c0), lg = *(const f32x2*)(lng + c0), lb = *(const f32x2*)(lnb + c0);
    const f32x2 wb0 = *(const f32x2*)(cbw + c0), wb1 = *(const f32x2*)(cbw + 512 + c0), wb2 = *(const f32x2*)(cbw + 1024 + c0);
    const int per_grp = (M / 32) / NGRP, nit = (per_grp - xr + XR - 1) / XR;
#define CV_BAR() do { asm volatile("s_waitcnt lgkmcnt(0)" ::: "memory"); __builtin_amdgcn_s_barrier(); asm volatile("" ::: "memory"); } while (0)
#define CV_T0(k_) ((xg * per_grp + xr + (k_) * XR) * 32 + grp * CR)
#define CV_LOAD(XW, k_) do { const int t0_ = CV_T0(k_); conv_load<0>(XW, G1 + (size_t)(t0_ - 30) * NG1 + c0, t0_ & (SEQ - 1), std::make_integer_sequence<int, CV_EARLY>{}); } while (0)
#define CV_BODY(XW, k_) do { const int t0 = CV_T0(k_), tl = t0 & (SEQ - 1); \
        conv_load<CV_EARLY>(XW, G1 + (size_t)(t0 - 30) * NG1 + c0, tl, std::make_integer_sequence<int, CR + 30 - CV_EARLY>{}); \
        f32x2 acc[CR]; \
        _Pragma("unroll") for (int i = 0; i < CR; ++i) acc[i] = cb; \
        conv_all(acc, w, XW, std::make_integer_sequence<int, CR + 30>{}); \
        const bf16_t* ps = G1 + (size_t)t0 * NG1 + 512 + c0; const bf16_t* bg = G1 + (size_t)t0 * NG1 + 1024 + c0; \
        unsigned pa = 0u, pb = 0u; if (tl != 0) { pa = *(const unsigned*)(ps - 2 * (size_t)NG1); pb = *(const unsigned*)(ps - (size_t)NG1); } \
        float S, Q; \
        { float sv[CR]; _Pragma("unroll") for (int i = 0; i < CR; ++i) sv[i] = acc[i].x + acc[i].y; S = xreduce16(sv, lane); } \
        { float qv[CR]; _Pragma("unroll") for (int i = 0; i < CR; ++i) qv[i] = acc[i].x * acc[i].x + acc[i].y * acc[i].y; Q = xreduce16(qv, lane); } \
        if ((lane & 3) == 0) *(LAS f32x2*)(red + ((grp * 4 + wv) * CR + (lane >> 2)) * 2) = (f32x2){S, Q}; \
        CV_BAR(); \
        if (t8 < CR) { float s_ = 0.f, q_ = 0.f; \
            _Pragma("unroll") for (int x = 0; x < 4; ++x) { const f32x2 t = *(const LAS f32x2*)(red + ((grp * 4 + x) * CR + t8) * 2); s_ += t.x; q_ += t.y; } \
            const float mean = s_ * (1.0f / 512.0f), var = q_ * (1.0f / 512.0f) - mean * mean; \
            *(LAS f32x2*)(st + (grp * CR + t8) * 2) = (f32x2){mean, __builtin_amdgcn_rsqf(var + LN_EPS)}; } \
        CV_BAR(); \
        bf16_t* dst = MX + (size_t)t0 * D + c0; \
        _Pragma("unroll") for (int i = 0; i < CR; ++i) { const f32x2 ms = *(const LAS f32x2*)(st + (grp * CR + i) * 2); \
            const float y0 = (acc[i].x - ms.x) * ms.y * lg.x + lb.x, y1 = (acc[i].y - ms.x) * ms.y * lg.y + lb.y; \
            *(unsigned*)(dst + (size_t)i * D) = cvt_pk_bf16(y0 * fast_sigmoid(y0), y1 * fast_sigmoid(y1)); } \
          \
        float p2x = bf_lo(pa), p2y = bf_hi(pa), p1x = bf_lo(pb), p1y = bf_hi(pb); \
        _Pragma("unroll") for (int i = 0; i < CR; ++i) { const unsigned pvi = __builtin_nontemporal_load((const unsigned*)(ps + (size_t)i * NG1)), gvi = __builtin_nontemporal_load((const unsigned*)(bg + (size_t)i * NG1)); const float px = bf_lo(pvi), py = bf_hi(pvi); \
            const float ox = bf_lo(gvi) * (wb0.x * p2x + wb1.x * p1x + wb2.x * px), oy = bf_hi(gvi) * (wb0.y * p2y + wb1.y * p1y + wb2.y * py); \
            *(unsigned*)(dst + (size_t)i * D + 512) = cvt_pk_bf16(ox, oy); \
            p2x = p1x; p2y = p1y; p1x = px; p1y = py; } } while (0)
    unsigned xa[CR + 30], xb[CR + 30];
    if (nit > 0) CV_LOAD(xa, 0);
    for (int k = 0; k < nit; k += 2) {
        const bool has1 = k + 1 < nit, has2 = k + 2 < nit;
        if (has1) CV_LOAD(xb, k + 1);
        CV_BODY(xa, k);
        if (has1) { if (has2) CV_LOAD(xa, k + 2); CV_BODY(xb, k + 1); }
    }
#undef CV_BAR
#undef CV_T0
#undef CV_LOAD
#undef CV_BODY
}

constexpr int SG_STRIDE = 272, SG_TILE = 128 * SG_STRIDE, SG_STAT = 0, SG_GAIN = 16384, SG_TILES = 24576;
__device__ __forceinline__ void sgu_phase(const Params& P, const bf16_t* U, const bf16_t* V, bf16_t* Y, LAS unsigned char* lds, int NGRP, int xg, int xr, int XR) {
    const f32x2* VST = (const f32x2*)(P.ws + WS_VST); const bf16_t* WSB = (const bf16_t*)(P.ws + WS_WSB);
    const float* lvg = P.in[12]; const float* lvb = P.in[13]; const float* bs = P.in[15];
    int tid_ = threadIdx.x; asm volatile("" : "+v"(tid_));
    const int tid = tid_, wid = __builtin_amdgcn_readfirstlane(tid >> 6), lane = tid & 63, fr = lane & 15, fq = lane >> 4;
    const int wt = wid >> 1, wcn = wid & 1;
    LAS float* stat = (LAS float*)(lds + SG_STAT);
    LAS float* gain = (LAS float*)(lds + SG_GAIN);
    LAS unsigned char* tiles = lds + SG_TILES;
    const int lr = tid >> 4, lc = tid & 15;
    const int trb = ((lane & 15) >> 2) * SG_STRIDE + (lane & 3) * 32 + fq * 8 * SG_STRIDE + wcn * 128;
    const int per_grp = (M / 128) / NGRP, vblk = xg * per_grp + xr, G = XR;
    int nch = (per_grp - xr + XR - 1) / XR; if (nch > 16) nch = 16;
    const int NIT = nch * 8;
    for (int i = tid; i < nch * 128; i += NTHR) { const int row = (vblk + G * (i >> 7)) * 128 + (i & 127);
        const f32x4* p = (const f32x4*)(VST + (size_t)row * 16); float sm = 0.f, q = 0.f;
#pragma unroll
        for (int x = 0; x < 8; ++x) { const f32x4 t = p[x]; sm += t.x + t.z; q += t.y + t.w; }
        const float mean = sm * (1.0f / 1024.0f), var = q * (1.0f / 1024.0f) - mean * mean;
        *(LAS f32x2*)(stat + i * 2) = (f32x2){mean, __builtin_amdgcn_rsqf(var + LN_EPS)}; }
    for (int i = tid; i < 1024; i += NTHR) { gain[i] = lvg[i]; gain[1024 + i] = lvb[i]; }
    u32x4 vr[4]; bf16x8 af[2][4]; u32x4 ur[2][2]; float bsv[2];
#define SG_LOAD(n_, VR, AF, UR, BSV, LDA_) do { const int g_ = (n_) / nch, row0_ = (vblk + G * ((n_) - g_ * nch)) * 128; \
        _Pragma("unroll") for (int i = 0; i < 4; ++i) VR[i] = __builtin_nontemporal_load((const u32x4*)(V + (size_t)(row0_ + lr + 32 * i) * D + g_ * 128 + lc * 8)); \
        const bf16_t* wsg_ = WSB + (size_t)(g_ * 128 + 32 * wt + fr) * 128 + 8 * fq; \
        if (LDA_) { _Pragma("unroll") for (int mb = 0; mb < 2; ++mb) { _Pragma("unroll") for (int kk = 0; kk < 4; ++kk) AF[mb][kk] = *(const bf16x8*)(wsg_ + (size_t)(16 * mb) * 128 + 32 * kk); } } \
        _Pragma("unroll") for (int mb = 0; mb < 2; ++mb) { \
            const int tloc_ = 32 * wt + 16 * mb + fr; const size_t ro_ = (size_t)(row0_ + tloc_) * D + g_ * 128 + 64 * wcn + 16 * fq; BSV[mb] = bs[g_ * 128 + tloc_]; \
            _Pragma("unroll") for (int h2 = 0; h2 < 2; ++h2) UR[mb][h2] = __builtin_nontemporal_load((const u32x4*)(U + ro_ + 8 * h2)); } } while (0)
    SG_LOAD(0, vr, af, ur, bsv, true);
    __syncthreads();
    for (int n = 0; n < NIT; ++n) {
        const int g = n / nch, ci = n - g * nch, row0 = (vblk + G * ci) * 128;
        LAS unsigned char* tile = tiles + (n & 1) * SG_TILE;
        { const f32x4 g0 = *(const LAS f32x4*)(gain + g * 128 + lc * 8), g1 = *(const LAS f32x4*)(gain + g * 128 + lc * 8 + 4);
          const f32x4 b0 = *(const LAS f32x4*)(gain + 1024 + g * 128 + lc * 8), b1 = *(const LAS f32x4*)(gain + 1024 + g * 128 + lc * 8 + 4);
#pragma unroll
          for (int i = 0; i < 4; ++i) { const int rr = lr + 32 * i; const f32x2 ms = *(const LAS f32x2*)(stat + (ci * 128 + rr) * 2);
            const u32x4 raw = vr[i]; const float mu = ms.x, rs = ms.y;
            u32x4 o;
            o.x = cvt_pk_bf16((bf_lo(raw.x) - mu) * rs * g0[0] + b0[0], (bf_hi(raw.x) - mu) * rs * g0[1] + b0[1]);
            o.y = cvt_pk_bf16((bf_lo(raw.y) - mu) * rs * g0[2] + b0[2], (bf_hi(raw.y) - mu) * rs * g0[3] + b0[3]);
            o.z = cvt_pk_bf16((bf_lo(raw.z) - mu) * rs * g1[0] + b1[0], (bf_hi(raw.z) - mu) * rs * g1[1] + b1[1]);
            o.w = cvt_pk_bf16((bf_lo(raw.w) - mu) * rs * g1[2] + b1[2], (bf_hi(raw.w) - mu) * rs * g1[3] + b1[3]);
            *(LAS u32x4*)(tile + rr * SG_STRIDE + lc * 16) = o; } }
        __syncthreads();
        u32x4 vrn[4]; bf16x8 afn[2][4]; u32x4 urn[2][2]; float bsn[2];
        { const int nn = (n + 1 < NIT) ? n + 1 : n; const bool newg = (nn / nch) != g;
#pragma unroll
          for (int mb = 0; mb < 2; ++mb)
#pragma unroll
              for (int k = 0; k < 4; ++k) afn[mb][k] = af[mb][k];
          SG_LOAD(nn, vrn, afn, urn, bsn, newg); }
        f32x4 acc[2][4];
#pragma unroll
        for (int mb = 0; mb < 2; ++mb)
#pragma unroll
            for (int nb = 0; nb < 4; ++nb) acc[mb][nb] = (f32x4){0.f, 0.f, 0.f, 0.f};
#pragma unroll
        for (int kk = 0; kk < 4; ++kk) {
#pragma unroll
            for (int nb = 0; nb < 4; ++nb) {
                const LAS unsigned char* tp = tile + trb + kk * 32 * SG_STRIDE + nb * 8;
                const s16x4 lo = __builtin_amdgcn_ds_read_tr16_b64_v4i16((LAS s16x4*)(tp));
                const s16x4 hi = __builtin_amdgcn_ds_read_tr16_b64_v4i16((LAS s16x4*)(tp + 4 * SG_STRIDE));
                const bf16x8 bf = __builtin_shufflevector(lo, hi, 0, 1, 2, 3, 4, 5, 6, 7);
#pragma unroll
                for (int mb = 0; mb < 2; ++mb) acc[mb][nb] = __builtin_amdgcn_mfma_f32_16x16x32_bf16(bf, af[mb][kk], acc[mb][nb], 0, 0, 0);
            }
        }
#pragma unroll
        for (int mb = 0; mb < 2; ++mb) { const int tloc = 32 * wt + 16 * mb + fr;
            const size_t ro = (size_t)(row0 + tloc) * D + g * 128 + 64 * wcn + 16 * fq; const float bb = bsv[mb];
#pragma unroll
            for (int h2 = 0; h2 < 2; ++h2) { const u32x4 uv = ur[mb][h2]; const f32x4 a0 = acc[mb][2 * h2], a1 = acc[mb][2 * h2 + 1];
                u32x4 o; o.x = cvt_pk_bf16(bf_lo(uv.x) * (a0[0] + bb), bf_hi(uv.x) * (a0[1] + bb)); o.y = cvt_pk_bf16(bf_lo(uv.y) * (a0[2] + bb), bf_hi(uv.y) * (a0[3] + bb));
                o.z = cvt_pk_bf16(bf_lo(uv.z) * (a1[0] + bb), bf_hi(uv.z) * (a1[1] + bb)); o.w = cvt_pk_bf16(bf_lo(uv.w) * (a1[2] + bb), bf_hi(uv.w) * (a1[3] + bb));
                *(u32x4*)(Y + ro + 8 * h2) = o; } }
#pragma unroll
        for (int i = 0; i < 4; ++i) vr[i] = vrn[i];
#pragma unroll
        for (int mb = 0; mb < 2; ++mb) { bsv[mb] = bsn[mb];
#pragma unroll
            for (int k = 0; k < 4; ++k) af[mb][k] = afn[mb][k];
            ur[mb][0] = urn[mb][0]; ur[mb][1] = urn[mb][1]; }
    }
#undef SG_LOAD
}

#define XB_TMO      128
#define XB_XCNT(j)  (256  + 64 * (j))
#define XB_XSUB(j)  (1280 + 64 * (j))
#define XB_XGEN(j)  (2304 + 64 * (j))
#define XB_TOP      3328
#define XB_TOPGEN   3392
#define XB_LSUB(j)  (3456 + 64 * (j))
#define XB_PCNT(pm) (4480 + 16 * (pm))
#define XCD_BAR_WORDS (4480 + 16 * 128)
#define XB_SPIN_CAP (1u << 18)
__device__ __forceinline__ unsigned xb_ld(unsigned* p)              { return __hip_atomic_load(p, __ATOMIC_RELAXED, __HIP_MEMORY_SCOPE_AGENT); }
__device__ __forceinline__ unsigned xb_add(unsigned* p, unsigned v) { return __hip_atomic_fetch_add(p, v, __ATOMIC_RELAXED, __HIP_MEMORY_SCOPE_AGENT); }
__device__ __forceinline__ unsigned xb_xcc_id() { return (unsigned)__builtin_amdgcn_s_getreg((3 << 11) | 20) & 0xFu; }
#define XB_SPIN(cond, bar) do { unsigned _sp = 0; while (cond) { __builtin_amdgcn_s_sleep(1); \
    if ((++_sp & 255u) == 0u) { if (xb_ld(&(bar)[XB_TMO])) break; if (_sp > XB_SPIN_CAP) { atomicAdd(&(bar)[XB_TMO], 1u); break; } } } } while (0)
struct XcdBarrier { unsigned* bar; unsigned x; volatile LAS unsigned* st; };
__device__ __forceinline__ XcdBarrier xcd_barrier_post(unsigned* bar, volatile LAS unsigned* st) {
    XcdBarrier b; b.bar = bar; b.x = xb_xcc_id(); b.st = st;
    if (threadIdx.x == 0) st[2] = xb_add(&bar[XB_XCNT(b.x)], 1u);
    return b;
}
__device__ __forceinline__ void xcd_barrier_complete(unsigned* bar, unsigned x, unsigned& nloc, unsigned& nx) {
    const unsigned G = gridDim.x * gridDim.y * gridDim.z;
    unsigned sum, cnt, mine, sp = 0u;
    for (;;) {
        sum = 0u; cnt = 0u; mine = 0u;
#pragma unroll
        for (unsigned j = 0; j < 16; ++j) { const unsigned c = xb_ld(&bar[XB_XCNT(j)]); sum += c; cnt += (c > 0u) ? 1u : 0u; mine = (j == x) ? c : mine; }
        if (sum == G) break;
        __builtin_amdgcn_s_sleep(1);
        if ((++sp & 255u) == 0u) { if (xb_ld(&bar[XB_TMO])) break; if (sp > XB_SPIN_CAP) { atomicAdd(&bar[XB_TMO], 1u); break; } }
    }
    nloc = mine > 0u ? mine : 1u; nx = cnt > 0u ? cnt : 1u;
}
__device__ __forceinline__ void xcd_barrier(const XcdBarrier& b) {
    asm volatile("s_waitcnt vmcnt(0)" ::: "memory");
    __syncthreads();
    if (threadIdx.x == 0) {
        unsigned* bar = b.bar;
        __builtin_amdgcn_s_waitcnt(0);
        unsigned nloc = b.st[0], nx = b.st[1];
        if (nloc == 0u) { xcd_barrier_complete(bar, b.x, nloc, nx); b.st[0] = nloc; b.st[1] = nx; }
        const unsigned old = xb_add(&bar[XB_XSUB(b.x)], 1u);
        const unsigned gen = old / nloc;
        if (old + 1u == (gen + 1u) * nloc) {
            __builtin_amdgcn_fence(__ATOMIC_RELEASE, "agent");
            asm volatile("s_waitcnt vmcnt(0)" ::: "memory");
            const unsigned og = xb_add(&bar[XB_TOP], 1u);
            const unsigned tg = og / nx;
            if (og + 1u == (tg + 1u) * nx) xb_add(&bar[XB_TOPGEN], 1u);
            else XB_SPIN(xb_ld(&bar[XB_TOPGEN]) == tg, bar);
            __builtin_amdgcn_fence(__ATOMIC_ACQUIRE, "agent");
            xb_add(&bar[XB_XGEN(b.x)], 1u);
            asm volatile("s_waitcnt vmcnt(0)" ::: "memory");
        } else {
            XB_SPIN(xb_ld(&bar[XB_XGEN(b.x)]) == gen, bar);
            __builtin_amdgcn_fence(__ATOMIC_ACQUIRE, "agent");
            asm volatile("s_waitcnt vmcnt(0)" ::: "memory");
        }
    }
    __syncthreads();
}

__device__ __forceinline__ void xcd_local_barrier(const XcdBarrier& b, unsigned nloc) {
    asm volatile("s_waitcnt vmcnt(0)" ::: "memory");
    __syncthreads();
    if (threadIdx.x == 0) {
        unsigned* bar = b.bar;
        __builtin_amdgcn_s_waitcnt(0);
        const unsigned old = xb_add(&bar[XB_LSUB(b.x)], 1u);
        const unsigned target = (old / nloc + 1u) * nloc;
        XB_SPIN(xb_ld(&bar[XB_LSUB(b.x)]) < target, bar);
        __builtin_amdgcn_fence(__ATOMIC_ACQUIRE, "agent");
        asm volatile("s_waitcnt vmcnt(0)" ::: "memory");
    }
    __syncthreads();
}
__device__ __forceinline__ void xcd_classify(const XcdBarrier& b) {
    if (threadIdx.x == 0) {
        const unsigned G = gridDim.x; unsigned cnt = 0u, dense = 0u; bool uni = (G % 8u) == 0u;
#pragma unroll
        for (unsigned j = 0; j < 16; ++j) { const unsigned c = xb_ld(&b.bar[XB_XCNT(j)]); if (c > 0u) { ++cnt; if (c != G / 8u) uni = false; if (j < b.x) ++dense; } }
        b.st[3] = (uni && cnt == 8u) ? 1u : 0u; b.st[4] = dense;
    }
    __syncthreads();
}
__global__ void __launch_bounds__(NTHR, 2) fwd_megakernel(Params P) {
    extern __shared__ __attribute__((aligned(16))) unsigned char lds_raw[];
    LAS unsigned char* lds = (LAS unsigned char*)lds_raw;
    cg::grid_group grid = cg::this_grid();
    const int tid = threadIdx.x, lane = tid & 63, wave = __builtin_amdgcn_readfirstlane(tid >> 6);
    const int G = gridDim.x, bx = blockIdx.x;
    const int vblk = (G % 8 == 0) ? (bx % 8) * (G / 8) + bx / 8 : bx;
    const int NGRP0 = (G % 8 == 0) ? 8 : 1, xg0 = bx % NGRP0, xr0 = bx / NGRP0, XR0 = G / NGRP0;
    unsigned char* ws = P.ws;
    volatile LAS unsigned* misc = (volatile LAS unsigned*)(lds + 131072);
    if (tid < 16) misc[tid] = 0u;
    __syncthreads();
    const XcdBarrier xbar = xcd_barrier_post((unsigned*)(ws + WS_BAR), misc);
    bf16_t* XB = (bf16_t*)(ws + WS_XB);
    float* SS0 = (float*)(ws + WS_SS); float* SS1 = SS0 + (size_t)M * 16; float* SS2 = SS1 + (size_t)M * 16; float* SS3 = SS2 + (size_t)M * 16; float* SS4 = SS3 + (size_t)M * 16;
    bf16_t* WIN0 = (bf16_t*)(ws + WS_WIN0); bf16_t* WOUT0 = (bf16_t*)(ws + WS_WOUT0); bf16_t* W1_0 = (bf16_t*)(ws + WS_W1_0); bf16_t* W2_0 = (bf16_t*)(ws + WS_W2_0);
    bf16_t* WIN1 = (bf16_t*)(ws + WS_WIN1); bf16_t* WOUT1 = (bf16_t*)(ws + WS_WOUT1); bf16_t* W1_1 = (bf16_t*)(ws + WS_W1_1); bf16_t* W2_1 = (bf16_t*)(ws + WS_W2_1);

    {
        LAS float* scr = (LAS float*)(lds + wave * 16384);
        const int gw = vblk * NWAVES + wave, NGW = G * NWAVES;
        constexpr int I0 = 16 * 40, I1 = 16 * 16, I2 = 16 * 64, I3 = 64 * 16, I4 = 16 * 32, I5 = 16 * 16, I6 = 16 * 64, I7 = 64 * 16;
        constexpr int NITEMS = I0 + I1 + I2 + I3 + I4 + I5 + I6 + I7;
        for (int it = gw; it < NITEMS; it += NGW) {
            int r = it;
            if (r < I0) { tr_item(P.in[2], D, NIN0, WIN0, P.in[1], 1, scr, r, lane); continue; } r -= I0;
            if (r < I1) { tr_item(P.in[8], D, D, WOUT0, nullptr, 0, scr, r, lane); continue; } r -= I1;
            if (r < I2) { tr_item(P.in[18], D, FF, W1_0, P.in[17], 0, scr, r, lane); continue; } r -= I2;
            if (r < I3) { tr_item(P.in[19], FF, D, W2_0, nullptr, 0, scr, r, lane); continue; } r -= I3;
            if (r < I4) { tr_item(P.in[10], D, NIN1, WIN1, P.in[9], 0, scr, r, lane); continue; } r -= I4;
            if (r < I5) { tr_item(P.in[16], D, D, WOUT1, nullptr, 0, scr, r, lane); continue; } r -= I5;
            if (r < I6) { tr_item(P.in[18] + (size_t)D * FF, D, FF, W1_1, P.in[17] + D, 0, scr, r, lane); continue; } r -= I6;
            tr_item(P.in[19] + (size_t)FF * D, FF, D, W2_1, nullptr, 0, scr, r, lane);
        }
        { bf16_t* WSB = (bf16_t*)(ws + WS_WSB); const float* wsrc = P.in[14];
          for (int i = vblk * NTHR + tid; i < 8 * 128 * 128 / 2; i += G * NTHR) { const int e = 2 * i, s = e & 127, t = (e >> 7) & 127; const f32x2 v = *(const f32x2*)(wsrc + e);
              ((unsigned*)WSB)[i] = cvt_pk_bf16(s <= t ? v.x : 0.f, (s + 1) <= t ? v.y : 0.f); } }
        const float* x = P.in[0];
        const int RPG = M / NGRP0, rbase = xg0 * RPG, lw = xr0 * NWAVES + wave, LW = XR0 * NWAVES;
        for (int r0 = lw; r0 < RPG; r0 += 4 * LW) {
            f32x4 v[4][4];
#pragma unroll
            for (int u = 0; u < 4; ++u) { const int row = rbase + ((r0 + u * LW < RPG) ? r0 + u * LW : r0); const f32x4* xr = (const f32x4*)(x + (size_t)row * D) + lane;
#pragma unroll
                for (int j = 0; j < 4; ++j) v[u][j] = __builtin_nontemporal_load(xr + 64 * j); }
#pragma unroll
            for (int u = 0; u < 4; ++u) { const int row = rbase + r0 + u * LW; if (r0 + u * LW < RPG) { float s = 0.f;
#pragma unroll
                for (int j = 0; j < 4; ++j) { const f32x4 t = v[u][j]; s += (t.x * t.x + t.y * t.y) + (t.z * t.z + t.w * t.w);
                    u32x2 o; o.x = cvt_pk_bf16(t.x, t.y); o.y = cvt_pk_bf16(t.z, t.w); *(u32x2*)(XB + (size_t)row * D + 4 * lane + 256 * j) = o; }
                s += __shfl_xor(s, 1); s += __shfl_xor(s, 2);
                if ((lane & 3) == 0) SS0[(size_t)row * 16 + (lane >> 2)] = s; } }
        }
    }
    if (P.ws == nullptr) grid.sync();
    xcd_barrier(xbar);
    xcd_classify(xbar);
    const bool fast = misc[3] != 0u; const unsigned nloc = misc[0];
    const int NGRP = 8, xg = fast ? (int)misc[4] : bx % NGRP, xr = fast ? (int)misc[2] : bx / NGRP, XR = G / NGRP;
    const int cg_ = fast ? xr * 8 + xg : bx;
    bf16_t* const G1w = (bf16_t*)(ws + WS_R + (size_t)xg * (20 * MiB)); bf16_t* const Uw = (bf16_t*)(ws + WS_R + (size_t)xg * (24 * MiB));
    bf16_t* const Vw = (bf16_t*)(ws + WS_R + 8 * MiB + (size_t)xg * (24 * MiB)); bf16_t* const MXw = (bf16_t*)(ws + WS_R + 16 * MiB + (size_t)xg * (24 * MiB));
#define SEAM() do { if (fast) xcd_local_barrier(xbar, nloc); else xcd_barrier(xbar); } while (0)
    const LAS float* const rs_tab = (const LAS float*)(lds + pg8::STAGE_BYTES + 256);
    { pg8::Gemm g{XB, WIN0, M, NIN0, D}; pg8::StaticOrder S; S.init(M, NIN0, G, cg_); pg8::EpiInEven E{G1w, SS0, rs_tab};
      pg8::gemm_phase<pg8::EpiInEven, pg8::StaticOrder, true, true>(lds, g, S, E); }
    SEAM();
    conv_phase(P, G1w, MXw, lds, NGRP, xg, xr, XR);
    SEAM();
    { pg8::Gemm g{MXw, WOUT0, M, D, D}; pg8::StaticOrder S; S.init(M, D, G, cg_); pg8::EpiRes E{XB, XB, SS1};
      pg8::gemm_phase<pg8::EpiRes, pg8::StaticOrder, true, true>(lds, g, S, E); }
    SEAM();
    { pg8::Gemm g{XB, W1_0, M, FF, D}; pg8::StaticOrder S; S.init(M, FF, G, cg_); pg8::EpiHid E{(bf16_t*)(ws + WS_HID), SS1, rs_tab};
      pg8::gemm_phase<pg8::EpiHid, pg8::StaticOrder, true, true>(lds, g, S, E); }
    SEAM();
    { pg8::Gemm g{(const bf16_t*)(ws + WS_HID), W2_0, M, D, FF}; pg8::StaticOrder S; S.init(M, D, G, cg_);
      pg8::EpiRes E{XB, XB, SS2};
      pg8::gemm_phase<pg8::EpiRes, pg8::StaticOrder, true, true>(lds, g, S, E); }
    SEAM();
    { pg8::Gemm g{XB, WIN1, M, NIN1, D}; pg8::StaticOrder S; S.init(M, NIN1, G, cg_);
      pg8::EpiInOdd E{Uw, Vw, SS2, P.in[11], (f32x2*)(ws + WS_VST), rs_tab};
      pg8::gemm_phase<pg8::EpiInOdd, pg8::StaticOrder, true, true>(lds, g, S, E); }
    SEAM();
    sgu_phase(P, Uw, Vw, MXw, lds, NGRP, xg, xr, XR);
    SEAM();
    { pg8::Gemm g{MXw, WOUT1, M, D, D}; pg8::StaticOrder S; S.init(M, D, G, cg_);
      pg8::EpiRes E{XB, XB, SS3};
      pg8::gemm_phase<pg8::EpiRes, pg8::StaticOrder, true, true>(lds, g, S, E); }
    SEAM();
    { pg8::Gemm g{XB, W1_1, M, FF, D}; pg8::StaticOrder S; S.init(M, FF, G, cg_); pg8::EpiHid E{(bf16_t*)(ws + WS_HID), SS3, rs_tab};
      pg8::gemm_phase<pg8::EpiHid, pg8::StaticOrder, true, true>(lds, g, S, E); }
    SEAM();
    { pg8::Gemm g{(const bf16_t*)(ws + WS_HID), W2_1, M, D, FF}; pg8::StaticOrder S; S.init(M, D, G, cg_);
      unsigned* const bw = (unsigned*)(ws + WS_BAR);
      pg8::EpiResFinal E{XB, P.out, P.in[20], (unsigned*)(ws + 60 * MiB), bw + XB_PCNT(0), bw + XB_TMO, (LAS float*)(lds + pg8::STAGE_BYTES + 256)};
      pg8::gemm_phase<pg8::EpiResFinal, pg8::StaticOrder, true, true>(lds, g, S, E); }
}

extern "C" void kernel_launch(void* const* d_in, const int* in_sizes, int n_in, void* d_out, int out_size, void* d_ws, size_t ws_size, hipStream_t stream) {
    static int grid_blocks = 0;
    if (grid_blocks == 0) {
        if (n_in != 21 || in_sizes[0] != M * D || out_size != M * D || ws_size < WS_END) { fprintf(stderr, "kernel_launch: unexpected shapes (n_in %d in0 %d out %d ws %zu)\n", n_in, n_in > 0 ? in_sizes[0] : -1, out_size, ws_size); grid_blocks = -1; return; }
        int dev = 0, cus = 0, per_cu = 0;
        (void)hipGetDevice(&dev); (void)hipDeviceGetAttribute(&cus, hipDeviceAttributeMultiprocessorCount, dev);
        if (hipFuncSetAttribute((const void*)fwd_megakernel, hipFuncAttributeMaxDynamicSharedMemorySize, LDS_BYTES) != hipSuccess) { fprintf(stderr, "kernel_launch: hipFuncSetAttribute failed\n"); grid_blocks = -1; return; }
        if (hipOccupancyMaxActiveBlocksPerMultiprocessor(&per_cu, (const void*)fwd_megakernel, NTHR, LDS_BYTES) != hipSuccess || per_cu < 1) { fprintf(stderr, "kernel_launch: occupancy query says %d\n", per_cu); per_cu = 1; }
        (void)hipGetLastError();
        if (cus % 8 != 0 || cus < 128) { fprintf(stderr, "kernel_launch: needs a CU count that is a multiple of 8 and >= 128 (got %d)\n", cus); grid_blocks = -1; return; }
        grid_blocks = cus * 1;
    }
    if (grid_blocks < 0) return;
    if (hipMemsetAsync((char*)d_ws + WS_BAR, 0, XCD_BAR_WORDS * 4, stream) != hipSuccess) { fprintf(stderr, "kernel_launch: memset of the barrier words failed\n"); return; }
    Params p{};
    for (int i = 0; i < 21; ++i) p.in[i] = (const float*)d_in[i];
    p.out = (float*)d_out; p.ws = (unsigned char*)d_ws;
    void* args[] = {&p};
    hipError_t e = hipLaunchCooperativeKernel((const void*)fwd_megakernel, dim3(grid_blocks), dim3(NTHR), args, LDS_BYTES, stream);
    if (e != hipSuccess) fprintf(stderr, "cooperative launch failed: %s (grid %d)\n", hipGetErrorString(e), grid_blocks);
}
```

```cpp
#include <hip/hip_runtime.h>
#include <hip/hip_cooperative_groups.h>
#include <cstdio>
#include <utility>
namespace cg = cooperative_groups;

#define LAS __attribute__((address_space(3)))
typedef unsigned short bf16_t;
typedef short bf16x8 __attribute__((ext_vector_type(8)));
typedef short s16x4 __attribute__((ext_vector_type(4)));
typedef float f32x4 __attribute__((ext_vector_type(4)));
typedef float f32x2 __attribute__((ext_vector_type(2)));
typedef unsigned u32x4 __attribute__((ext_vector_type(4)));
typedef unsigned u32x2 __attribute__((ext_vector_type(2)));

constexpr int D = 1024, SEQ = 2048, M = 16 * 2048, FF = 4096, NIN0 = 2560, NG1 = 1536, NIN1 = 2048;
constexpr float RMS_EPS = 1e-6f, LN_EPS = 1e-5f;
constexpr size_t MiB = 1u << 20;
constexpr size_t WS_WIN0 = 0, WS_WOUT0 = 5 * MiB, WS_W1_0 = 7 * MiB, WS_W2_0 = 15 * MiB, WS_WIN1 = 23 * MiB, WS_WOUT1 = 27 * MiB, WS_W1_1 = 29 * MiB, WS_W2_1 = 37 * MiB, WS_WSB = 45 * MiB;
constexpr size_t WS_SS = 46 * MiB  , WS_VST = 56 * MiB  , WS_XB = 64 * MiB  ;
constexpr size_t WS_R = 128 * MiB  , WS_HID = WS_R, WS_END = 384 * MiB, WS_BAR = 62 * MiB;

__device__ __forceinline__ unsigned cvt_pk_bf16(float lo, float hi) { unsigned r; asm volatile("v_cvt_pk_bf16_f32 %0, %1, %2" : "=v"(r) : "v"(lo), "v"(hi)); return r; }
__device__ __forceinline__ float bf_lo(unsigned v) { return __builtin_bit_cast(float, v << 16); }
__device__ __forceinline__ float bf_hi(unsigned v) { return __builtin_bit_cast(float, v & 0xffff0000u); }
__device__ __forceinline__ float relu1(float x) { float r; asm("v_max_f32_e32 %0, 0, %1" : "=v"(r) : "v"(x)); return r; }
__device__ __forceinline__ float fast_sigmoid(float x) { return __builtin_amdgcn_rcpf(1.0f + __builtin_amdgcn_exp2f(x * -1.44269504089f)); }

namespace pg8 {
constexpr int BM = 256, BK = 64, HALF = 128, HTB = HALF * BK * 2, STAGE_BYTES = 8 * HTB, NXCD = 8, WGM = 8;
__host__ __device__ __forceinline__ int lds_byte(int r, int c) { const int st = (r >> 4) * 2 + (c >> 5), rr = r & 15, cc = c & 31, ob = rr * 64 + cc * 2; return st * 1024 + (ob ^ (((ob >> 9) & 1) << 5)); }
__host__ __device__ __forceinline__ void stage_rc(int b, int& R, int& C) { const int st = b / 1024, sb = b % 1024, swz = sb ^ (((sb >> 9) & 1) << 5); R = (st >> 1) * 16 + swz / 64; C = (st & 1) * 32 + (swz % 64) / 2; }
__host__ __device__ __forceinline__ int perm32(int rho) { const int n = rho >> 4, i = rho & 15; return 8 * (i >> 2) + 4 * n + (i & 3); }
struct Unit { int pm, pn; };
struct Gemm { const bf16_t* A; const bf16_t* Bt; int M, N, K; };
struct StaticOrder {
    int nM, nN, nwg, G, c;
    __device__ void init(int M_, int N_, int G_, int c_) { nM = M_ / BM; nN = N_ / BM; nwg = nM * nN; G = G_; c = c_; }
    __device__ bool next(int i, Unit& u) const {
        const long L = (long)i * G + c; if (L >= nwg) return false;
        int wgid = (int)L; { const int q = nwg / NXCD, r = nwg % NXCD, xcd = wgid % NXCD, off = wgid / NXCD; wgid = (xcd < r ? xcd * (q + 1) : r * (q + 1) + (xcd - r) * q) + off; }
        const int nig = WGM * nN, gid = wgid / nig, fm = gid * WGM, gsz = (nM - fm) < WGM ? (nM - fm) : WGM;
        u.pm = fm + ((wgid % nig) % gsz); u.pn = (wgid % nig) / gsz; return true;
    }
};
__device__ __forceinline__ f32x2 gelu_pk(f32x2 v) {
    const f32x2 av = __builtin_elementwise_abs(v), d = av * 0.2316418882f + 1.0f;
    f32x2 t; t.x = __builtin_amdgcn_rcpf(d.x); t.y = __builtin_amdgcn_rcpf(d.y);
    f32x2 q = t * 0.5307027145f + (-0.7265760135f); q = q * t + 0.7107068705f; q = q * t + (-0.142248368f); q = q * t + 0.127414796f; q = q * t;
    const f32x2 s = (v * v) * (-0.72134752044f);
    f32x2 e; e.x = __builtin_amdgcn_exp2f(s.x); e.y = __builtin_amdgcn_exp2f(s.y);
    const f32x2 m = v * (q * e), r = v - m;
    f32x2 o; o.x = v.x < 0.f ? m.x : r.x; o.y = v.y < 0.f ? m.y : r.y; return o;
}
__device__ __forceinline__ float row_rs(const float* ss, int row) {
    const f32x4* p = (const f32x4*)(ss + (size_t)row * 16); f32x4 a = p[0], b = p[1], c = p[2], d = p[3]; a = (a + b) + (c + d);
    return __builtin_amdgcn_rsqf(((a.x + a.y) + (a.z + a.w)) * (1.0f / 1024.0f) + RMS_EPS);
}

struct EpiInEven {
    static constexpr bool PERM = true, AFTER_DRAIN = false;
    static constexpr bool NEEDS_RS = true;
    bf16_t* G1; const float* ss; const LAS float* rs_tab;
    __device__ __forceinline__ void operator()(const f32x4 (&acc)[2][2][4][2], const Unit& u, int ui, int wr, int wc, int fr, int fq) const {
        const LAS float* rsp = rs_tab + ui * 256 + wr * 64 + fr; float rsv[2][4];
#pragma unroll
        for (int ai = 0; ai < 2; ++ai)
#pragma unroll
            for (int m = 0; m < 4; ++m) rsv[ai][m] = rsp[ai * HALF + m * 16];
        const int row0 = u.pm * BM + wr * 64 + fr;
#pragma unroll
        for (int ai = 0; ai < 2; ++ai)
#pragma unroll
            for (int m = 0; m < 4; ++m) {
                const int row = row0 + ai * HALF + m * 16; const float r = rsv[ai][m];
                bf16_t* rowp = G1 + (size_t)row * NG1 + wc * 32 + 8 * fq;
                if (u.pn < 4) {
                    f32x4 v0 = acc[ai][0][m][0] * r, v1 = acc[ai][0][m][1] * r, g0 = acc[ai][1][m][0] * r, g1 = acc[ai][1][m][1] * r;
#pragma unroll
                    for (int j = 0; j < 4; ++j) { v0[j] *= fast_sigmoid(g0[j]); v1[j] *= fast_sigmoid(g1[j]); }
                    u32x4 w; w.x = cvt_pk_bf16(v0[0], v0[1]); w.y = cvt_pk_bf16(v0[2], v0[3]); w.z = cvt_pk_bf16(v1[0], v1[1]); w.w = cvt_pk_bf16(v1[2], v1[3]);
                    *(u32x4*)(rowp + 128 * u.pn) = w;
                } else if (u.pn < 8) {
                    const float r2 = r * r; f32x4 v0 = acc[ai][0][m][0] * acc[ai][1][m][0] * r2, v1 = acc[ai][0][m][1] * acc[ai][1][m][1] * r2;
                    u32x4 w; w.x = cvt_pk_bf16(v0[0], v0[1]); w.y = cvt_pk_bf16(v0[2], v0[3]); w.z = cvt_pk_bf16(v1[0], v1[1]); w.w = cvt_pk_bf16(v1[2], v1[3]);
                    *(u32x4*)(rowp + 512 + 128 * (u.pn - 4)) = w;
                } else {
#pragma unroll
                    for (int bj = 0; bj < 2; ++bj) { f32x4 v0 = acc[ai][bj][m][0] * r, v1 = acc[ai][bj][m][1] * r;
                        u32x4 w; w.x = cvt_pk_bf16(v0[0], v0[1]); w.y = cvt_pk_bf16(v0[2], v0[3]); w.z = cvt_pk_bf16(v1[0], v1[1]); w.w = cvt_pk_bf16(v1[2], v1[3]);
                        *(u32x4*)(rowp + 1024 + 256 * (u.pn - 8) + 128 * bj) = w; }
                }
            }
    }
};
struct EpiRes {
    static constexpr bool PERM = true, AFTER_DRAIN = false;
    static constexpr bool NEEDS_RS = false;
    const bf16_t* res; bf16_t* XB; float* ssout;
    __device__ __forceinline__ void operator()(const f32x4 (&acc)[2][2][4][2], const Unit& u, int ui, int wr, int wc, int fr, int fq) const {
        const int row0 = u.pm * BM + wr * 64 + fr, col0 = u.pn * BM + wc * 32 + 8 * fq;
        u32x4 rv[2][4][2];
#pragma unroll
        for (int ai = 0; ai < 2; ++ai)
#pragma unroll
            for (int m = 0; m < 4; ++m)
#pragma unroll
                for (int bj = 0; bj < 2; ++bj) rv[ai][m][bj] = *(const u32x4*)(res + (size_t)(row0 + ai * HALF + m * 16) * D + col0 + bj * HALF);
#pragma unroll
        for (int ai = 0; ai < 2; ++ai) {
#pragma unroll
            for (int m = 0; m < 4; ++m) {
                const int row = row0 + ai * HALF + m * 16; const size_t off = (size_t)row * D + col0; float q = 0.f;
#pragma unroll
                for (int bj = 0; bj < 2; ++bj) {
                    const u32x4 r = rv[ai][m][bj];
                    const f32x4 h0 = (f32x4){bf_lo(r.x), bf_hi(r.x), bf_lo(r.y), bf_hi(r.y)} + acc[ai][bj][m][0], h1 = (f32x4){bf_lo(r.z), bf_hi(r.z), bf_lo(r.w), bf_hi(r.w)} + acc[ai][bj][m][1];
                    q += (h0[0] * h0[0] + h0[1] * h0[1]) + (h0[2] * h0[2] + h0[3] * h0[3]) + (h1[0] * h1[0] + h1[1] * h1[1]) + (h1[2] * h1[2] + h1[3] * h1[3]);
                    u32x4 w; w.x = cvt_pk_bf16(h0[0], h0[1]); w.y = cvt_pk_bf16(h0[2], h0[3]); w.z = cvt_pk_bf16(h1[0], h1[1]); w.w = cvt_pk_bf16(h1[2], h1[3]);
                    *(u32x4*)(XB + off + bj * HALF) = w;
                }
                q += __shfl_xor(q, 16); q += __shfl_xor(q, 32);
                if (fq == 0) ssout[(size_t)row * 16 + u.pn * 4 + wc] = q;
            }
            asm volatile("" ::: "memory");
        }
    }
};
struct EpiResFinal {
    static constexpr bool PERM = true, AFTER_DRAIN = false, NEEDS_RS = false;
    const bf16_t* res; float* out; const float* gfin; unsigned* xq; unsigned* cnt; unsigned* tmo; LAS float* sl;
    __device__ __forceinline__ void operator()(f32x4 (&acc)[2][2][4][2], const Unit& u, int ui, int wr, int wc, int fr, int fq) const {
        const int row0 = u.pm * BM + wr * 64 + fr, col0 = u.pn * BM + wc * 32 + 8 * fq, tid = threadIdx.x;
        LAS float* part = sl; LAS float* rsT = sl + 1024;
#pragma unroll
        for (int ai = 0; ai < 2; ++ai) {
            u32x4 rv[4][2];
#pragma unroll
            for (int m = 0; m < 4; ++m)
#pragma unroll
                for (int bj = 0; bj < 2; ++bj) rv[m][bj] = *(const u32x4*)(res + (size_t)(row0 + ai * HALF + m * 16) * D + col0 + bj * HALF);
#pragma unroll
            for (int m = 0; m < 4; ++m) { float q = 0.f;
#pragma unroll
                for (int bj = 0; bj < 2; ++bj) { const u32x4 r = rv[m][bj];
                    const f32x4 h0 = (f32x4){bf_lo(r.x), bf_hi(r.x), bf_lo(r.y), bf_hi(r.y)} + acc[ai][bj][m][0], h1 = (f32x4){bf_lo(r.z), bf_hi(r.z), bf_lo(r.w), bf_hi(r.w)} + acc[ai][bj][m][1];
                    q += (h0[0] * h0[0] + h0[1] * h0[1]) + (h0[2] * h0[2] + h0[3] * h0[3]) + (h1[0] * h1[0] + h1[1] * h1[1]) + (h1[2] * h1[2] + h1[3] * h1[3]);
                    acc[ai][bj][m][0] = h0; acc[ai][bj][m][1] = h1; }
                q += __shfl_xor(q, 16); q += __shfl_xor(q, 32);
                if (fq == 0) part[(ai * HALF + wr * 64 + m * 16 + fr) * 4 + wc] = q; }
        }
        asm volatile("s_waitcnt lgkmcnt(0)" ::: "memory"); __builtin_amdgcn_s_barrier(); asm volatile("" ::: "memory");
        if (tid < 256) { const f32x4 p = *(const LAS f32x4*)(part + tid * 4);
            __hip_atomic_store(xq + (size_t)(u.pm * BM + tid) * 4 + u.pn, __builtin_bit_cast(unsigned, (p.x + p.y) + (p.z + p.w)), __ATOMIC_RELAXED, __HIP_MEMORY_SCOPE_AGENT); }
        asm volatile("s_waitcnt vmcnt(0)" ::: "memory"); __builtin_amdgcn_s_barrier(); asm volatile("" ::: "memory");
        if (tid == 0) { unsigned* c = cnt + 16 * u.pm; __hip_atomic_fetch_add(c, 1u, __ATOMIC_RELAXED, __HIP_MEMORY_SCOPE_AGENT);
            unsigned sp = 0u;
            while (__hip_atomic_load(c, __ATOMIC_RELAXED, __HIP_MEMORY_SCOPE_AGENT) < 4u) { __builtin_amdgcn_s_sleep(1);
                if ((++sp & 255u) == 0u) { if (__hip_atomic_load(tmo, __ATOMIC_RELAXED, __HIP_MEMORY_SCOPE_AGENT)) break; if (sp > (1u << 18)) { atomicAdd(tmo, 1u); break; } } }
            __builtin_amdgcn_fence(__ATOMIC_ACQUIRE, "agent"); asm volatile("s_waitcnt vmcnt(0)" ::: "memory"); }
        __builtin_amdgcn_s_barrier(); asm volatile("" ::: "memory");
        if (tid < 256) { const unsigned* p = xq + (size_t)(u.pm * BM + tid) * 4; float sm = 0.f;
#pragma unroll
            for (int t = 0; t < 4; ++t) sm += __builtin_bit_cast(float, __hip_atomic_load(p + t, __ATOMIC_RELAXED, __HIP_MEMORY_SCOPE_AGENT));
            rsT[tid] = __builtin_amdgcn_rsqf(sm * (1.0f / 1024.0f) + RMS_EPS); }
        asm volatile("s_waitcnt lgkmcnt(0)" ::: "memory"); __builtin_amdgcn_s_barrier(); asm volatile("" ::: "memory");
        f32x4 gv[2][2];
#pragma unroll
        for (int bj = 0; bj < 2; ++bj)
#pragma unroll
            for (int n = 0; n < 2; ++n) gv[bj][n] = *(const f32x4*)(gfin + col0 + bj * HALF + 4 * n);
#pragma unroll
        for (int ai = 0; ai < 2; ++ai)
#pragma unroll
            for (int m = 0; m < 4; ++m) { const int rl = ai * HALF + wr * 64 + m * 16 + fr; const float r = rsT[rl]; float* orow = out + (size_t)(u.pm * BM + rl) * D + col0;
#pragma unroll
                for (int bj = 0; bj < 2; ++bj)
#pragma unroll
                    for (int n = 0; n < 2; ++n) *(f32x4*)(orow + bj * HALF + 4 * n) = acc[ai][bj][m][n] * r * gv[bj][n]; }
    }
};
struct EpiHid {
    static constexpr bool PERM = true, AFTER_DRAIN = false;
    static constexpr bool NEEDS_RS = true;
    bf16_t* O; const float* ss; const LAS float* rs_tab;
    __device__ __forceinline__ void operator()(const f32x4 (&acc)[2][2][4][2], const Unit& u, int ui, int wr, int wc, int fr, int fq) const {
        const LAS float* rsp = rs_tab + ui * 256 + wr * 64 + fr; float rsv[2][4];
#pragma unroll
        for (int ai = 0; ai < 2; ++ai)
#pragma unroll
            for (int m = 0; m < 4; ++m) rsv[ai][m] = rsp[ai * HALF + m * 16];
        const int row0 = u.pm * BM + wr * 64 + fr, col0 = u.pn * BM + wc * 32 + 8 * fq;
#pragma unroll
        for (int ai = 0; ai < 2; ++ai)
#pragma unroll
            for (int m = 0; m < 4; ++m) {
                const int row = row0 + ai * HALF + m * 16; const float r = rsv[ai][m], r2 = r * r;
                bf16_t* rowp = O + (size_t)row * FF + col0;
#pragma unroll
                for (int bj = 0; bj < 2; ++bj) {
                    f32x4 v0, v1;
#pragma unroll
                    for (int j = 0; j < 4; ++j) { v0[j] = relu1(acc[ai][bj][m][0][j]); v1[j] = relu1(acc[ai][bj][m][1][j]); }
                    v0 = v0 * v0 * r2; v1 = v1 * v1 * r2;
                    u32x4 w; w.x = cvt_pk_bf16(v0[0], v0[1]); w.y = cvt_pk_bf16(v0[2], v0[3]); w.z = cvt_pk_bf16(v1[0], v1[1]); w.w = cvt_pk_bf16(v1[2], v1[3]);
                    __builtin_nontemporal_store(w, (u32x4*)(rowp + bj * HALF)); }
            }
    }
};
struct EpiInOdd {
    static constexpr bool PERM = true, AFTER_DRAIN = false;
    static constexpr bool NEEDS_RS = true;
    bf16_t* U; bf16_t* V; const float* ss; const float* bias; f32x2* vst; const LAS float* rs_tab;
    __device__ __forceinline__ void operator()(const f32x4 (&acc)[2][2][4][2], const Unit& u, int ui, int wr, int wc, int fr, int fq) const {
        const LAS float* rsp = rs_tab + ui * 256 + wr * 64 + fr; float rsv[2][4];
#pragma unroll
        for (int ai = 0; ai < 2; ++ai)
#pragma unroll
            for (int m = 0; m < 4; ++m) rsv[ai][m] = rsp[ai * HALF + m * 16];
        const int row0 = u.pm * BM + wr * 64 + fr, colt = wc * 32 + 8 * fq; const bool isv = u.pn >= 4;
        bf16_t* base = isv ? V : U; const int col0 = (isv ? u.pn - 4 : u.pn) * BM + colt;
        f32x4 bv[2][2];
#pragma unroll
        for (int bj = 0; bj < 2; ++bj)
#pragma unroll
            for (int n = 0; n < 2; ++n) bv[bj][n] = *(const f32x4*)(bias + u.pn * BM + colt + bj * HALF + 4 * n);
#pragma unroll
        for (int ai = 0; ai < 2; ++ai)
#pragma unroll
            for (int m = 0; m < 4; ++m) {
                const int row = row0 + ai * HALF + m * 16; const float r = rsv[ai][m]; float s = 0.f, q = 0.f;
                bf16_t* rowp = base + (size_t)row * D + col0;
#pragma unroll
                for (int bj = 0; bj < 2; ++bj) {
                    f32x4 v0 = acc[ai][bj][m][0] * r + bv[bj][0], v1 = acc[ai][bj][m][1] * r + bv[bj][1];
                    f32x2 a = gelu_pk((f32x2){v0[0], v0[1]}), b = gelu_pk((f32x2){v0[2], v0[3]}), c = gelu_pk((f32x2){v1[0], v1[1]}), d = gelu_pk((f32x2){v1[2], v1[3]});
                    s += (a.x + a.y) + (b.x + b.y) + (c.x + c.y) + (d.x + d.y);
                    q += (a.x * a.x + a.y * a.y) + (b.x * b.x + b.y * b.y) + (c.x * c.x + c.y * c.y) + (d.x * d.x + d.y * d.y);
                    u32x4 w; w.x = cvt_pk_bf16(a.x, a.y); w.y = cvt_pk_bf16(b.x, b.y); w.z = cvt_pk_bf16(c.x, c.y); w.w = cvt_pk_bf16(d.x, d.y);
                    *(u32x4*)(rowp + bj * HALF) = w; }
                if (isv) { s += __shfl_xor(s, 16); s += __shfl_xor(s, 32); q += __shfl_xor(q, 16); q += __shfl_xor(q, 32);
                    if (fq == 0) vst[(size_t)row * 16 + (u.pn - 4) * 4 + wc] = (f32x2){s, q}; }
            }
    }
};

template <class Epi, class Sched, bool ALIGN_EPI = false, bool SP2 = false>
__device__ __forceinline__ void gemm_phase(LAS unsigned char* lds, const Gemm g, const Sched& S, const Epi& E) {
    int tid_ = threadIdx.x; asm volatile("" : "+v"(tid_));
    const int tid = tid_, wid = __builtin_amdgcn_readfirstlane(tid >> 6), lane = tid & 63, wr = wid >> 2, wc = wid & 3, fr = lane & 15, fq = lane >> 4;
    const int K = g.K, nt = K / BK;
    unsigned voffA[2], voffB[2];
#pragma unroll
    for (int i = 0; i < 2; ++i) { int R, C; stage_rc(tid * 16 + i * 8192, R, C); const int Rb = Epi::PERM ? ((R & ~31) + perm32(R & 31)) : R;
        voffA[i] = (unsigned)(R * K + C) * 2u; voffB[i] = (unsigned)(Rb * K + C) * 2u; }
    const size_t kstep = (size_t)(BK * 2);
    const size_t hstep = (size_t)HALF * K * 2;
    const size_t tstep = 2 * hstep;
    const unsigned ldsw = (unsigned)wid * 1024u;
    const int aoff = lds_byte(wr * 64 + fr, fq * 8), boff = lds_byte(wc * 32 + fr, fq * 8);
#define PG8_SA(b, h) (((b) * 2 + (h)) * HTB)
#define PG8_SB(b, h) ((4 + (b) * 2 + (h)) * HTB)
#define PG8_STAGE(bufoff, gbase, voff) do { _Pragma("unroll") for (int _i = 0; _i < 2; ++_i) \
        __builtin_amdgcn_global_load_lds((const unsigned*)((const char*)(gbase) + (voff)[_i]), (LAS unsigned*)(lds + (bufoff) + ldsw + _i * 8192), 16, 0, 0); } while (0)
#define PG8_LDA(dst, b, h) do { _Pragma("unroll") for (int m = 0; m < 4; ++m) _Pragma("unroll") for (int k = 0; k < 2; ++k) dst[m][k] = *(const LAS bf16x8*)(lds + PG8_SA(b, h) + aoff + m * 2048 + k * 1024); } while (0)
#define PG8_LDB(dst, b, h) do { _Pragma("unroll") for (int n = 0; n < 2; ++n) _Pragma("unroll") for (int k = 0; k < 2; ++k) dst[n][k] = *(const LAS bf16x8*)(lds + PG8_SB(b, h) + boff + n * 2048 + k * 1024); } while (0)
#define PG8_MMA(ai, bj, At, Bt) do { __builtin_amdgcn_s_setprio(1); _Pragma("unroll") for (int m = 0; m < 4; ++m) _Pragma("unroll") for (int n = 0; n < 2; ++n) _Pragma("unroll") for (int k = 0; k < 2; ++k) \
        acc[ai][bj][m][n] = __builtin_amdgcn_mfma_f32_16x16x32_bf16(Bt[n][k], At[m][k], acc[ai][bj][m][n], 0, 0, 0); __builtin_amdgcn_s_setprio(0); } while (0)
#define PG8_WAIT_V(n) asm volatile("s_waitcnt vmcnt(" #n ")" ::: "memory")
#define PG8_WAIT_L(n) asm volatile("s_waitcnt lgkmcnt(" #n ")" ::: "memory")
#define PG8_BAR __builtin_amdgcn_s_barrier()
#define PG8_SCHED __builtin_amdgcn_sched_barrier(0)
    Unit cur, nxt; int ui = 0;
    if (!S.next(0, cur)) return;
    f32x4 acc[2][2][4][2];
#pragma unroll
    for (int a = 0; a < 2; ++a)
#pragma unroll
        for (int b = 0; b < 2; ++b)
#pragma unroll
            for (int m = 0; m < 4; ++m)
#pragma unroll
                for (int n = 0; n < 2; ++n) acc[a][b][m][n] = (f32x4){0.f, 0.f, 0.f, 0.f};
    bf16x8 At[4][2], B0[2][2], B1[2][2];
    const char* cA = (const char*)g.A + (size_t)cur.pm * tstep; const char* cB = (const char*)g.Bt + (size_t)cur.pn * tstep;
    if constexpr (SP2) {
        PG8_STAGE(PG8_SB(0, 0), cB, voffB); PG8_STAGE(PG8_SB(0, 1), cB + hstep, voffB); PG8_STAGE(PG8_SA(0, 0), cA, voffA); PG8_STAGE(PG8_SA(0, 1), cA + hstep, voffA);
        if constexpr (Epi::NEEDS_RS) {
            LAS float* tab = (LAS float*)(lds + STAGE_BYTES + 256); Unit pu;
            for (int i = tid >> 8; S.next(i, pu); i += 2) tab[i * 256 + (tid & 255)] = row_rs(E.ss, pu.pm * BM + (tid & 255));
            PG8_WAIT_L(0);
        }
        if (wr == 1) PG8_BAR;
        PG8_WAIT_V(2); PG8_BAR;
        PG8_STAGE(PG8_SB(1, 0), cB + kstep, voffB); PG8_STAGE(PG8_SA(1, 0), cA + kstep, voffA); PG8_STAGE(PG8_SB(1, 1), cB + hstep + kstep, voffB);
        PG8_WAIT_V(6); PG8_BAR;
    } else {
        PG8_STAGE(PG8_SB(0, 0), cB, voffB); PG8_STAGE(PG8_SA(0, 0), cA, voffA); PG8_STAGE(PG8_SB(0, 1), cB + hstep, voffB); PG8_STAGE(PG8_SA(0, 1), cA + hstep, voffA);
        if (wr == 1) PG8_BAR;
        PG8_WAIT_V(4); PG8_BAR;
        PG8_STAGE(PG8_SB(1, 0), cB + kstep, voffB); PG8_STAGE(PG8_SA(1, 0), cA + kstep, voffA); PG8_STAGE(PG8_SB(1, 1), cB + hstep + kstep, voffB);
        PG8_WAIT_V(6); PG8_BAR;
    }
    for (;;) {
        const bool has_next = S.next(ui + 1, nxt);
        const char* nA = has_next ? (const char*)g.A + (size_t)nxt.pm * tstep : cA; const char* nB = has_next ? (const char*)g.Bt + (size_t)nxt.pn * tstep : cB;
        for (int t = 0; t < nt; t += 2) {
            const bool last = (t == nt - 2);
            const char* a1 = cA + (size_t)(t + 1) * kstep;
            const char* a2 = last ? nA : cA + (size_t)(t + 2) * kstep; const char* b2 = last ? nB : cB + (size_t)(t + 2) * kstep;
            const char* a3 = a2 + kstep; const char* b3 = b2 + kstep;
            if constexpr (SP2) {
            PG8_LDB(B0, 0, 0); PG8_LDB(B1, 0, 1); PG8_SCHED; PG8_LDA(At, 0, 0); PG8_STAGE(PG8_SA(1, 1), a1 + hstep, voffA);
            PG8_WAIT_V(8); PG8_WAIT_L(0); PG8_BAR; PG8_MMA(0, 0, At, B0); PG8_MMA(0, 1, At, B1); PG8_BAR; PG8_SCHED;
            PG8_LDA(At, 0, 1); PG8_STAGE(PG8_SB(0, 0), b2, voffB); PG8_STAGE(PG8_SB(0, 1), b2 + hstep, voffB); PG8_STAGE(PG8_SA(0, 0), a2, voffA);
            PG8_WAIT_V(8); PG8_WAIT_L(0); PG8_BAR; PG8_MMA(1, 0, At, B0); PG8_MMA(1, 1, At, B1); PG8_BAR; PG8_SCHED;
            PG8_LDB(B0, 1, 0); PG8_LDB(B1, 1, 1); PG8_SCHED; PG8_LDA(At, 1, 0); PG8_STAGE(PG8_SA(0, 1), a2 + hstep, voffA);
            PG8_WAIT_V(8); PG8_WAIT_L(0); PG8_BAR; PG8_MMA(0, 0, At, B0); PG8_MMA(0, 1, At, B1); PG8_BAR; PG8_SCHED;
            PG8_LDA(At, 1, 1); PG8_STAGE(PG8_SB(1, 0), b3, voffB); PG8_STAGE(PG8_SB(1, 1), b3 + hstep, voffB); PG8_STAGE(PG8_SA(1, 0), a3, voffA);
            PG8_WAIT_V(8); PG8_WAIT_L(0); PG8_BAR; PG8_MMA(1, 0, At, B0); PG8_MMA(1, 1, At, B1); PG8_BAR; PG8_SCHED;
            } else {
            PG8_LDB(B0, 0, 0); PG8_SCHED; PG8_LDA(At, 0, 0); PG8_STAGE(PG8_SA(1, 1), a1 + hstep, voffA);
            PG8_WAIT_L(8); PG8_BAR; PG8_WAIT_L(0); PG8_MMA(0, 0, At, B0); PG8_BAR; PG8_SCHED;
            PG8_LDB(B1, 0, 1); PG8_STAGE(PG8_SB(0, 0), b2, voffB);
            PG8_BAR; PG8_WAIT_L(0); PG8_MMA(0, 1, At, B1); PG8_BAR;
            PG8_LDA(At, 0, 1); PG8_STAGE(PG8_SA(0, 0), a2, voffA);
            PG8_BAR; PG8_WAIT_L(0); PG8_MMA(1, 0, At, B0); PG8_BAR; PG8_SCHED;
            PG8_STAGE(PG8_SB(0, 1), b2 + hstep, voffB);
            PG8_WAIT_V(6); PG8_BAR; PG8_MMA(1, 1, At, B1); PG8_BAR;
            PG8_LDB(B0, 1, 0); PG8_SCHED; PG8_LDA(At, 1, 0); PG8_STAGE(PG8_SA(0, 1), a2 + hstep, voffA);
            PG8_WAIT_L(8); PG8_BAR; PG8_WAIT_L(0); PG8_MMA(0, 0, At, B0); PG8_BAR; PG8_SCHED;
            PG8_LDB(B1, 1, 1); PG8_STAGE(PG8_SB(1, 0), b3, voffB);
            PG8_BAR; PG8_WAIT_L(0); PG8_MMA(0, 1, At, B1); PG8_BAR;
            PG8_LDA(At, 1, 1); PG8_STAGE(PG8_SA(1, 0), a3, voffA);
            PG8_BAR; PG8_WAIT_L(0); PG8_MMA(1, 0, At, B0); PG8_BAR; PG8_SCHED;
            PG8_STAGE(PG8_SB(1, 1), b3 + hstep, voffB);
            PG8_WAIT_V(6); PG8_BAR; PG8_MMA(1, 1, At, B1); PG8_BAR;
            }
        }
        if constexpr (ALIGN_EPI) { if (wr == 0) PG8_BAR; }
        E(acc, cur, ui, wr, wc, fr, fq);
        if (!has_next) break;
#pragma unroll
        for (int a = 0; a < 2; ++a)
#pragma unroll
            for (int b = 0; b < 2; ++b)
#pragma unroll
                for (int m = 0; m < 4; ++m)
#pragma unroll
                    for (int n = 0; n < 2; ++n) acc[a][b][m][n] = (f32x4){0.f, 0.f, 0.f, 0.f};
        cur = nxt; cA = nA; cB = nB; ++ui;
        if constexpr (ALIGN_EPI) { if (wr == 1) PG8_BAR; }
    }
    PG8_WAIT_V(0);
    if constexpr (!ALIGN_EPI) { if (wr == 0) PG8_BAR; }
    PG8_BAR;
#undef PG8_SA
#undef PG8_SB
#undef PG8_STAGE
#undef PG8_LDA
#undef PG8_LDB
#undef PG8_MMA
#undef PG8_WAIT_V
#undef PG8_WAIT_L
#undef PG8_BAR
#undef PG8_SCHED
}
}

constexpr int NWAVES = 8, NTHR = 512;
constexpr int LDS_BYTES = 131072 + 256 + 16 * 1024;
#define LDS_WAIT() asm volatile("s_waitcnt lgkmcnt(0)" ::: "memory")

__device__ __forceinline__ void tr_item(const float* W, int K, int N, bf16_t* WT, const float* gain, int mode, LAS float* scr, int item, int lane) {
    const int nblk = N / 64, kb = item / nblk, nb = item % nblk, k0 = 64 * kb, n0 = 64 * nb;
    int ns = n0;
    if (mode) { const int t = n0 >> 8, j = n0 & 255;
        if (t < 4) ns = (j < 128) ? 128 * t + j : 512 + 128 * t + (j - 128);
        else if (t < 8) ns = (j < 128) ? 1536 + 128 * (t - 4) + j : 2048 + 128 * (t - 4) + (j - 128);
        else ns = 1024 + 256 * (t - 8) + j; }
    const int r4 = lane >> 4, c4 = (lane & 15) * 4;
    f32x4 v[16];
#pragma unroll
    for (int i = 0; i < 16; ++i) v[i] = __builtin_nontemporal_load((const f32x4*)(W + (size_t)(k0 + 4 * i + r4) * N + ns + c4));
    if (gain) {
#pragma unroll
        for (int i = 0; i < 16; ++i) v[i] = v[i] * gain[k0 + 4 * i + r4];
    }
    const int c = lane & 7;
#pragma unroll
    for (int h = 0; h < 2; ++h) {
        if (((lane & 15) >> 3) == h) { const int cc = c4 - 32 * h;
#pragma unroll
            for (int i = 0; i < 16; ++i) { LAS float* d = scr + (4 * i + r4) * 33 + cc; d[0] = v[i][0]; d[1] = v[i][1]; d[2] = v[i][2]; d[3] = v[i][3]; } }
        LDS_WAIT(); asm volatile("" ::: "memory");
#pragma unroll
        for (int j = 0; j < 4; ++j) { const int n = (lane >> 3) + 8 * j; const LAS float* sp = scr + (8 * c) * 33 + n;
            u32x4 o; o.x = cvt_pk_bf16(sp[0 * 33], sp[1 * 33]); o.y = cvt_pk_bf16(sp[2 * 33], sp[3 * 33]); o.z = cvt_pk_bf16(sp[4 * 33], sp[5 * 33]); o.w = cvt_pk_bf16(sp[6 * 33], sp[7 * 33]);
            *(u32x4*)(WT + (size_t)(n0 + 32 * h + n) * K + k0 + 8 * c) = o; }
        LDS_WAIT(); asm volatile("" ::: "memory");
    }
}

struct Params { const float* in[21]; float* out; unsigned char* ws; };

constexpr int CR = 16;
template <int J, int I> __device__ __forceinline__ void conv_tap(f32x2 (&acc)[CR], const f32x2 (&w)[31], f32x2 x) {
    if constexpr (J - I >= 0 && J - I <= 30) acc[I] += w[J - I] * x;
}
template <int J, int... I> __device__ __forceinline__ void conv_row(f32x2 (&acc)[CR], const f32x2 (&w)[31], f32x2 x, std::integer_sequence<int, I...>) { (conv_tap<J, I>(acc, w, x), ...); }
template <int J> __device__ __forceinline__ void conv_j(f32x2 (&acc)[CR], const f32x2 (&w)[31], const unsigned (&xw)[CR + 30]) {
    const unsigned xv = xw[J];
    conv_row<J>(acc, w, (f32x2){bf_lo(xv), bf_hi(xv)}, std::make_integer_sequence<int, CR>{});
}
template <int... J> __device__ __forceinline__ void conv_all(f32x2 (&acc)[CR], const f32x2 (&w)[31], const unsigned (&xw)[CR + 30], std::integer_sequence<int, J...>) { (conv_j<J>(acc, w, xw), ...); }
template <int OFF, int... J> __device__ __forceinline__ void conv_load(unsigned (&xw)[CR + 30], const bf16_t* src, int tl, std::integer_sequence<int, J...>) {
    ((xw[OFF + J] = (tl - 30 + OFF + J >= 0) ? *(const unsigned*)(src + (size_t)(OFF + J) * NG1) : 0u), ...);
}
constexpr int CV_EARLY = 24;
__device__ __forceinline__ float xreduce16(const float (&v)[16], int lane) {
    float b[8], c[4], d[2], e;
    { const bool up = lane & 32;
#pragma unroll
      for (int i = 0; i < 8; ++i) { const float keep = up ? v[i + 8] : v[i], send = up ? v[i] : v[i + 8]; b[i] = keep + __shfl_xor(send, 32); } }
    { const bool up = lane & 16;
#pragma unroll
      for (int i = 0; i < 4; ++i) { const float keep = up ? b[i + 4] : b[i], send = up ? b[i] : b[i + 4]; c[i] = keep + __shfl_xor(send, 16); } }
    { const bool up = lane & 8;
#pragma unroll
      for (int i = 0; i < 2; ++i) { const float keep = up ? c[i + 2] : c[i], send = up ? c[i] : c[i + 2]; d[i] = keep + __shfl_xor(send, 8); } }
    { const bool up = lane & 4; const float keep = up ? d[1] : d[0], send = up ? d[0] : d[1]; e = keep + __shfl_xor(send, 4); }
    e += __shfl_xor(e, 2); e += __shfl_xor(e, 1);
    return e;
}

__device__ __forceinline__ void conv_phase(const Params& P, const bf16_t* G1, bf16_t* MX, LAS unsigned char* lds, int NGRP, int xg, int xr, int XR) {
    const float* caw = P.in[3]; const float* cab = P.in[4]; const float* lng = P.in[5]; const float* lnb = P.in[6]; const float* cbw = P.in[7];
    int tid_ = threadIdx.x; asm volatile("" : "+v"(tid_));
    const int tid = tid_, grp = tid >> 8, t8 = tid & 255, lane = tid & 63, wv = (tid >> 6) & 3;
    const int c0 = 2 * t8;
    LAS float* red = (LAS float*)lds;
    LAS float* st = (LAS float*)(lds + 4096);
    f32x2 w[31];
#pragma unroll
    for (int k = 0; k < 31; ++k) w[k] = *(const f32x2*)(caw + k * 512 + c0);
    const f32x2 cb = *(const f32x2*)(cab + c0), lg = *(const f32x2*)(lng + c0), lb = *(const f32x2*)(lnb + c0);
    const f32x4 wq0 = *(const f32x4*)(cbw + 4 * (t8 & 127)), wq1 = *(const f32x4*)(cbw + 512 + 4 * (t8 & 127)), wq2 = *(const f32x4*)(cbw + 1024 + 4 * (t8 & 127));
    const int per_grp = (M / 32) / NGRP, nit = (per_grp - xr + XR - 1) / XR;
#define CV_BAR() do { asm volatile("s_waitcnt lgkmcnt(0)" ::: "memory"); __builtin_amdgcn_s_barrier(); asm volatile("" ::: "memory"); } while (0)
#define CV_T0(k_) ((xg * per_grp + xr + (k_) * XR) * 32 + grp * CR)
#define CV_LOAD(XW, k_) do { const int t0_ = CV_T0(k_); conv_load<0>(XW, G1 + (size_t)(t0_ - 30) * NG1 + c0, t0_ & (SEQ - 1), std::make_integer_sequence<int, CV_EARLY>{}); } while (0)
#define CV_BODY(XW, k_) do { const int t0 = CV_T0(k_), tl = t0 & (SEQ - 1); \
        conv_load<CV_EARLY>(XW, G1 + (size_t)(t0 - 30) * NG1 + c0, tl, std::make_integer_sequence<int, CR + 30 - CV_EARLY>{}); \
        f32x2 acc[CR]; \
        _Pragma("unroll") for (int i = 0; i < CR; ++i) acc[i] = cb; \
        conv_all(acc, w, XW, std::make_integer_sequence<int, CR + 30>{}); \
        const bf16_t* ps = G1 + (size_t)t0 * NG1 + 512 + c0; const bf16_t* bg = G1 + (size_t)t0 * NG1 + 1024 + c0; \
        unsigned pa = 0u, pb = 0u; if (tl != 0) { pa = *(const unsigned*)(ps - 2 * (size_t)NG1); pb = *(const unsigned*)(ps - (size_t)NG1); } \
        float S, Q; \
        { float sv[CR]; _Pragma("unroll") for (int i = 0; i < CR; ++i) sv[i] = acc[i].x + acc[i].y; S = xreduce16(sv, lane); } \
        { float qv[CR]; _Pragma("unroll") for (int i = 0; i < CR; ++i) qv[i] = acc[i].x * acc[i].x + acc[i].y * acc[i].y; Q = xreduce16(qv, lane); } \
        if ((lane & 3) == 0) *(LAS f32x2*)(red + ((grp * 4 + wv) * CR + (lane >> 2)) * 2) = (f32x2){S, Q}; \
        CV_BAR(); \
        if (t8 < CR) { float s_ = 0.f, q_ = 0.f; \
            _Pragma("unroll") for (int x = 0; x < 4; ++x) { const f32x2 t = *(const LAS f32x2*)(red + ((grp * 4 + x) * CR + t8) * 2); s_ += t.x; q_ += t.y; } \
            const float mean = s_ * (1.0f / 512.0f), var = q_ * (1.0f / 512.0f) - mean * mean; \
            *(LAS f32x2*)(st + (grp * CR + t8) * 2) = (f32x2){mean, __builtin_amdgcn_rsqf(var + LN_EPS)}; } \
        CV_BAR(); \
        bf16_t* dst = MX + (size_t)t0 * D + c0; \
        _Pragma("unroll") for (int i = 0; i < CR; ++i) { const f32x2 ms = *(const LAS f32x2*)(st + (grp * CR + i) * 2); \
            const float y0 = (acc[i].x - ms.x) * ms.y * lg.x + lb.x, y1 = (acc[i].y - ms.x) * ms.y * lg.y + lb.y; \
            *(unsigned*)(dst + (size_t)i * D) = cvt_pk_bf16(y0 * fast_sigmoid(y0), y1 * fast_sigmoid(y1)); } \
          \
        { const int cq = t8 & 127, rb = t0 + 8 * (t8 >> 7); \
          const bf16_t* ps = G1 + (size_t)rb * NG1 + 512 + 4 * cq; const bf16_t* bg = G1 + (size_t)rb * NG1 + 1024 + 4 * cq; bf16_t* db = MX + (size_t)rb * D + 512 + 4 * cq; \
          u32x2 pa = (u32x2){0u, 0u}, pb = (u32x2){0u, 0u}; if ((rb & (SEQ - 1)) != 0) { pa = __builtin_nontemporal_load((const u32x2*)(ps - 2 * (size_t)NG1)); pb = __builtin_nontemporal_load((const u32x2*)(ps - (size_t)NG1)); } \
          f32x4 p2 = (f32x4){bf_lo(pa.x), bf_hi(pa.x), bf_lo(pa.y), bf_hi(pa.y)}, p1 = (f32x4){bf_lo(pb.x), bf_hi(pb.x), bf_lo(pb.y), bf_hi(pb.y)}; \
          _Pragma("unroll") for (int i = 0; i < 8; ++i) { const u32x2 pvi = __builtin_nontemporal_load((const u32x2*)(ps + (size_t)i * NG1)), gvi = __builtin_nontemporal_load((const u32x2*)(bg + (size_t)i * NG1)); \
              const f32x4 pc = (f32x4){bf_lo(pvi.x), bf_hi(pvi.x), bf_lo(pvi.y), bf_hi(pvi.y)}, gc = (f32x4){bf_lo(gvi.x), bf_hi(gvi.x), bf_lo(gvi.y), bf_hi(gvi.y)}; \
              const f32x4 o = gc * (wq0 * p2 + wq1 * p1 + wq2 * pc); \
              u32x2 ov; ov.x = cvt_pk_bf16(o[0], o[1]); ov.y = cvt_pk_bf16(o[2], o[3]); *(u32x2*)(db + (size_t)i * D) = ov; \
              p2 = p1; p1 = pc; } } } while (0)
    unsigned xa[CR + 30], xb[CR + 30];
    if (nit > 0) CV_LOAD(xa, 0);
    for (int k = 0; k < nit; k += 2) {
        const bool has1 = k + 1 < nit, has2 = k + 2 < nit;
        if (has1) CV_LOAD(xb, k + 1);
        CV_BODY(xa, k);
        if (has1) { if (has2) CV_LOAD(xa, k + 2); CV_BODY(xb, k + 1); }
    }
#undef CV_BAR
#undef CV_T0
#undef CV_LOAD
#undef CV_BODY
}

constexpr int SG_STRIDE = 272, SG_TILE = 128 * SG_STRIDE, SG_STAT = 0, SG_GAIN = 16384, SG_TILES = 24576;
__device__ __forceinline__ void sgu_phase(const Params& P, const bf16_t* U, const bf16_t* V, bf16_t* Y, LAS unsigned char* lds, int NGRP, int xg, int xr, int XR) {
    const f32x2* VST = (const f32x2*)(P.ws + WS_VST); const bf16_t* WSB = (const bf16_t*)(P.ws + WS_WSB);
    const float* lvg = P.in[12]; const float* lvb = P.in[13]; const float* bs = P.in[15];
    int tid_ = threadIdx.x; asm volatile("" : "+v"(tid_));
    const int tid = tid_, wid = __builtin_amdgcn_readfirstlane(tid >> 6), lane = tid & 63, fr = lane & 15, fq = lane >> 4;
    const int wt = wid >> 1, wcn = wid & 1;
    LAS float* stat = (LAS float*)(lds + SG_STAT);
    LAS float* gain = (LAS float*)(lds + SG_GAIN);
    LAS unsigned char* tiles = lds + SG_TILES;
    const int lr = tid >> 4, lc = tid & 15;
    const int trb = ((lane & 15) >> 2) * SG_STRIDE + (lane & 3) * 32 + fq * 8 * SG_STRIDE + wcn * 128;
    const int per_grp = (M / 128) / NGRP, vblk = xg * per_grp + xr, G = XR;
    int nch = (per_grp - xr + XR - 1) / XR; if (nch > 16) nch = 16;
    const int NIT = nch * 8;
    for (int i = tid; i < nch * 128; i += NTHR) { const int row = (vblk + G * (i >> 7)) * 128 + (i & 127);
        const f32x4* p = (const f32x4*)(VST + (size_t)row * 16); float sm = 0.f, q = 0.f;
#pragma unroll
        for (int x = 0; x < 8; ++x) { const f32x4 t = p[x]; sm += t.x + t.z; q += t.y + t.w; }
        const float mean = sm * (1.0f / 1024.0f), var = q * (1.0f / 1024.0f) - mean * mean;
        *(LAS f32x2*)(stat + i * 2) = (f32x2){mean, __builtin_amdgcn_rsqf(var + LN_EPS)}; }
    for (int i = tid; i < 1024; i += NTHR) { gain[i] = lvg[i]; gain[1024 + i] = lvb[i]; }
    u32x4 vr[4]; bf16x8 af[2][4]; u32x4 ur[2][2]; float bsv[2];
#define SG_LOAD(n_, VR, AF, UR, BSV, LDA_) do { const int g_ = (n_) / nch, row0_ = (vblk + G * ((n_) - g_ * nch)) * 128; \
        _Pragma("unroll") for (int i = 0; i < 4; ++i) VR[i] = __builtin_nontemporal_load((const u32x4*)(V + (size_t)(row0_ + lr + 32 * i) * D + g_ * 128 + lc * 8)); \
        const bf16_t* wsg_ = WSB + (size_t)(g_ * 128 + 32 * wt + fr) * 128 + 8 * fq; \
        if (LDA_) { _Pragma("unroll") for (int mb = 0; mb < 2; ++mb) { _Pragma("unroll") for (int kk = 0; kk < 4; ++kk) AF[mb][kk] = *(const bf16x8*)(wsg_ + (size_t)(16 * mb) * 128 + 32 * kk); } } \
        _Pragma("unroll") for (int mb = 0; mb < 2; ++mb) { \
            const int tloc_ = 32 * wt + 16 * mb + fr; const size_t ro_ = (size_t)(row0_ + tloc_) * D + g_ * 128 + 64 * wcn + 16 * fq; BSV[mb] = bs[g_ * 128 + tloc_]; \
            _Pragma("unroll") for (int h2 = 0; h2 < 2; ++h2) UR[mb][h2] = __builtin_nontemporal_load((const u32x4*)(U + ro_ + 8 * h2)); } } while (0)
    SG_LOAD(0, vr, af, ur, bsv, true);
    __syncthreads();
    for (int n = 0; n < NIT; ++n) {
        const int g = n / nch, ci = n - g * nch, row0 = (vblk + G * ci) * 128;
        LAS unsigned char* tile = tiles + (n & 1) * SG_TILE;
        { const f32x4 g0 = *(const LAS f32x4*)(gain + g * 128 + lc * 8), g1 = *(const LAS f32x4*)(gain + g * 128 + lc * 8 + 4);
          const f32x4 b0 = *(const LAS f32x4*)(gain + 1024 + g * 128 + lc * 8), b1 = *(const LAS f32x4*)(gain + 1024 + g * 128 + lc * 8 + 4);
#pragma unroll
          for (int i = 0; i < 4; ++i) { const int rr = lr + 32 * i; const f32x2 ms = *(const LAS f32x2*)(stat + (ci * 128 + rr) * 2);
            const u32x4 raw = vr[i]; const float mu = ms.x, rs = ms.y;
            u32x4 o;
            o.x = cvt_pk_bf16((bf_lo(raw.x) - mu) * rs * g0[0] + b0[0], (bf_hi(raw.x) - mu) * rs * g0[1] + b0[1]);
            o.y = cvt_pk_bf16((bf_lo(raw.y) - mu) * rs * g0[2] + b0[2], (bf_hi(raw.y) - mu) * rs * g0[3] + b0[3]);
            o.z = cvt_pk_bf16((bf_lo(raw.z) - mu) * rs * g1[0] + b1[0], (bf_hi(raw.z) - mu) * rs * g1[1] + b1[1]);
            o.w = cvt_pk_bf16((bf_lo(raw.w) - mu) * rs * g1[2] + b1[2], (bf_hi(raw.w) - mu) * rs * g1[3] + b1[3]);
            *(LAS u32x4*)(tile + rr * SG_STRIDE + lc * 16) = o; } }
        __syncthreads();
        u32x4 vrn[4]; bf16x8 afn[2][4]; u32x4 urn[2][2]; float bsn[2];
        { const int nn = (n + 1 < NIT) ? n + 1 : n; const bool newg = (nn / nch) != g;
#pragma unroll
          for (int mb = 0; mb < 2; ++mb)
#pragma unroll
              for (int k = 0; k < 4; ++k) afn[mb][k] = af[mb][k];
          SG_LOAD(nn, vrn, afn, urn, bsn, newg); }
        f32x4 acc[2][4];
#pragma unroll
        for (int mb = 0; mb < 2; ++mb)
#pragma unroll
            for (int nb = 0; nb < 4; ++nb) acc[mb][nb] = (f32x4){0.f, 0.f, 0.f, 0.f};
#pragma unroll
        for (int kk = 0; kk < 4; ++kk) {
#pragma unroll
            for (int nb = 0; nb < 4; ++nb) {
                const LAS unsigned char* tp = tile + trb + kk * 32 * SG_STRIDE + nb * 8;
                const s16x4 lo = __builtin_amdgcn_ds_read_tr16_b64_v4i16((LAS s16x4*)(tp));
                const s16x4 hi = __builtin_amdgcn_ds_read_tr16_b64_v4i16((LAS s16x4*)(tp + 4 * SG_STRIDE));
                const bf16x8 bf = __builtin_shufflevector(lo, hi, 0, 1, 2, 3, 4, 5, 6, 7);
#pragma unroll
                for (int mb = 0; mb < 2; ++mb) acc[mb][nb] = __builtin_amdgcn_mfma_f32_16x16x32_bf16(bf, af[mb][kk], acc[mb][nb], 0, 0, 0);
            }
        }
#pragma unroll
        for (int mb = 0; mb < 2; ++mb) { const int tloc = 32 * wt + 16 * mb + fr;
            const size_t ro = (size_t)(row0 + tloc) * D + g * 128 + 64 * wcn + 16 * fq; const float bb = bsv[mb];
#pragma unroll
            for (int h2 = 0; h2 < 2; ++h2) { const u32x4 uv = ur[mb][h2]; const f32x4 a0 = acc[mb][2 * h2], a1 = acc[mb][2 * h2 + 1];
                u32x4 o; o.x = cvt_pk_bf16(bf_lo(uv.x) * (a0[0] + bb), bf_hi(uv.x) * (a0[1] + bb)); o.y = cvt_pk_bf16(bf_lo(uv.y) * (a0[2] + bb), bf_hi(uv.y) * (a0[3] + bb));
                o.z = cvt_pk_bf16(bf_lo(uv.z) * (a1[0] + bb), bf_hi(uv.z) * (a1[1] + bb)); o.w = cvt_pk_bf16(bf_lo(uv.w) * (a1[2] + bb), bf_hi(uv.w) * (a1[3] + bb));
                *(u32x4*)(Y + ro + 8 * h2) = o; } }
#pragma unroll
        for (int i = 0; i < 4; ++i) vr[i] = vrn[i];
#pragma unroll
        for (int mb = 0; mb < 2; ++mb) { bsv[mb] = bsn[mb];
#pragma unroll
            for (int k = 0; k < 4; ++k) af[mb][k] = afn[mb][k];
            ur[mb][0] = urn[mb][0]; ur[mb][1] = urn[mb][1]; }
    }
#undef SG_LOAD
}

#define XB_TMO      128
#define XB_XCNT(j)  (256  + 64 * (j))
#define XB_XSUB(j)  (1280 + 64 * (j))
#define XB_XGEN(j)  (2304 + 64 * (j))
#define XB_TOP      3328
#define XB_TOPGEN   3392
#define XB_LSUB(j)  (3456 + 64 * (j))
#define XB_PCNT(pm) (4480 + 16 * (pm))
#define XCD_BAR_WORDS (4480 + 16 * 128)
#define XB_SPIN_CAP (1u << 18)
__device__ __forceinline__ unsigned xb_ld(unsigned* p)              { return __hip_atomic_load(p, __ATOMIC_RELAXED, __HIP_MEMORY_SCOPE_AGENT); }
__device__ __forceinline__ unsigned xb_add(unsigned* p, unsigned v) { return __hip_atomic_fetch_add(p, v, __ATOMIC_RELAXED, __HIP_MEMORY_SCOPE_AGENT); }
__device__ __forceinline__ unsigned xb_xcc_id() { return (unsigned)__builtin_amdgcn_s_getreg((3 << 11) | 20) & 0xFu; }
#define XB_SPIN(cond, bar) do { unsigned _sp = 0; while (cond) { __builtin_amdgcn_s_sleep(1); \
    if ((++_sp & 255u) == 0u) { if (xb_ld(&(bar)[XB_TMO])) break; if (_sp > XB_SPIN_CAP) { atomicAdd(&(bar)[XB_TMO], 1u); break; } } } } while (0)
struct XcdBarrier { unsigned* bar; unsigned x; volatile LAS unsigned* st; };
__device__ __forceinline__ XcdBarrier xcd_barrier_post(unsigned* bar, volatile LAS unsigned* st) {
    XcdBarrier b; b.bar = bar; b.x = xb_xcc_id(); b.st = st;
    if (threadIdx.x == 0) st[2] = xb_add(&bar[XB_XCNT(b.x)], 1u);
    return b;
}
__device__ __forceinline__ void xcd_barrier_complete(unsigned* bar, unsigned x, unsigned& nloc, unsigned& nx) {
    const unsigned G = gridDim.x * gridDim.y * gridDim.z;
    unsigned sum, cnt, mine, sp = 0u;
    for (;;) {
        sum = 0u; cnt = 0u; mine = 0u;
#pragma unroll
        for (unsigned j = 0; j < 16; ++j) { const unsigned c = xb_ld(&bar[XB_XCNT(j)]); sum += c; cnt += (c > 0u) ? 1u : 0u; mine = (j == x) ? c : mine; }
        if (sum == G) break;
        __builtin_amdgcn_s_sleep(1);
        if ((++sp & 255u) == 0u) { if (xb_ld(&bar[XB_TMO])) break; if (sp > XB_SPIN_CAP) { atomicAdd(&bar[XB_TMO], 1u); break; } }
    }
    nloc = mine > 0u ? mine : 1u; nx = cnt > 0u ? cnt : 1u;
}
__device__ __forceinline__ void xcd_barrier(const XcdBarrier& b) {
    asm volatile("s_waitcnt vmcnt(0)" ::: "memory");
    __syncthreads();
    if (threadIdx.x == 0) {
        unsigned* bar = b.bar;
        __builtin_amdgcn_s_waitcnt(0);
        unsigned nloc = b.st[0], nx = b.st[1];
        if (nloc == 0u) { xcd_barrier_complete(bar, b.x, nloc, nx); b.st[0] = nloc; b.st[1] = nx; }
        const unsigned old = xb_add(&bar[XB_XSUB(b.x)], 1u);
        const unsigned gen = old / nloc;
        if (old + 1u == (gen + 1u) * nloc) {
            __builtin_amdgcn_fence(__ATOMIC_RELEASE, "agent");
            asm volatile("s_waitcnt vmcnt(0)" ::: "memory");
            const unsigned og = xb_add(&bar[XB_TOP], 1u);
            const unsigned tg = og / nx;
            if (og + 1u == (tg + 1u) * nx) xb_add(&bar[XB_TOPGEN], 1u);
            else XB_SPIN(xb_ld(&bar[XB_TOPGEN]) == tg, bar);
            __builtin_amdgcn_fence(__ATOMIC_ACQUIRE, "agent");
            xb_add(&bar[XB_XGEN(b.x)], 1u);
            asm volatile("s_waitcnt vmcnt(0)" ::: "memory");
        } else {
            XB_SPIN(xb_ld(&bar[XB_XGEN(b.x)]) == gen, bar);
            __builtin_amdgcn_fence(__ATOMIC_ACQUIRE, "agent");
            asm volatile("s_waitcnt vmcnt(0)" ::: "memory");
        }
    }
    __syncthreads();
}

__device__ __forceinline__ void xcd_local_barrier(const XcdBarrier& b, unsigned nloc) {
    asm volatile("s_waitcnt vmcnt(0)" ::: "memory");
    __syncthreads();
    if (threadIdx.x == 0) {
        unsigned* bar = b.bar;
        __builtin_amdgcn_s_waitcnt(0);
        const unsigned old = xb_add(&bar[XB_LSUB(b.x)], 1u);
        const unsigned target = (old / nloc + 1u) * nloc;
        XB_SPIN(xb_ld(&bar[XB_LSUB(b.x)]) < target, bar);
        __builtin_amdgcn_fence(__ATOMIC_ACQUIRE, "agent");
        asm volatile("s_waitcnt vmcnt(0)" ::: "memory");
    }
    __syncthreads();
}
__device__ __forceinline__ void xcd_classify(const XcdBarrier& b) {
    if (threadIdx.x == 0) {
        const unsigned G = gridDim.x; unsigned cnt = 0u, dense = 0u; bool uni = (G % 8u) == 0u;
#pragma unroll
        for (unsigned j = 0; j < 16; ++j) { const unsigned c = xb_ld(&b.bar[XB_XCNT(j)]); if (c > 0u) { ++cnt; if (c != G / 8u) uni = false; if (j < b.x) ++dense; } }
        b.st[3] = (uni && cnt == 8u) ? 1u : 0u; b.st[4] = dense;
    }
    __syncthreads();
}
__global__ void __launch_bounds__(NTHR, 2) fwd_megakernel(Params P) {
    extern __shared__ __attribute__((aligned(16))) unsigned char lds_raw[];
    LAS unsigned char* lds = (LAS unsigned char*)lds_raw;
    cg::grid_group grid = cg::this_grid();
    const int tid = threadIdx.x, lane = tid & 63, wave = __builtin_amdgcn_readfirstlane(tid >> 6);
    const int G = gridDim.x, bx = blockIdx.x;
    const int vblk = (G % 8 == 0) ? (bx % 8) * (G / 8) + bx / 8 : bx;
    const int NGRP0 = (G % 8 == 0) ? 8 : 1, xg0 = bx % NGRP0, xr0 = bx / NGRP0, XR0 = G / NGRP0;
    unsigned char* ws = P.ws;
    volatile LAS unsigned* misc = (volatile LAS unsigned*)(lds + 131072);
    if (tid < 16) misc[tid] = 0u;
    __syncthreads();
    const XcdBarrier xbar = xcd_barrier_post((unsigned*)(ws + WS_BAR), misc);
    bf16_t* XB = (bf16_t*)(ws + WS_XB);
    float* SS0 = (float*)(ws + WS_SS); float* SS1 = SS0 + (size_t)M * 16; float* SS2 = SS1 + (size_t)M * 16; float* SS3 = SS2 + (size_t)M * 16; float* SS4 = SS3 + (size_t)M * 16;
    bf16_t* WIN0 = (bf16_t*)(ws + WS_WIN0); bf16_t* WOUT0 = (bf16_t*)(ws + WS_WOUT0); bf16_t* W1_0 = (bf16_t*)(ws + WS_W1_0); bf16_t* W2_0 = (bf16_t*)(ws + WS_W2_0);
    bf16_t* WIN1 = (bf16_t*)(ws + WS_WIN1); bf16_t* WOUT1 = (bf16_t*)(ws + WS_WOUT1); bf16_t* W1_1 = (bf16_t*)(ws + WS_W1_1); bf16_t* W2_1 = (bf16_t*)(ws + WS_W2_1);

    {
        LAS float* scr = (LAS float*)(lds + wave * 16384);
        const int gw = vblk * NWAVES + wave, NGW = G * NWAVES;
        constexpr int I0 = 16 * 40, I1 = 16 * 16, I2 = 16 * 64, I3 = 64 * 16, I4 = 16 * 32, I5 = 16 * 16, I6 = 16 * 64, I7 = 64 * 16;
        constexpr int NITEMS = I0 + I1 + I2 + I3 + I4 + I5 + I6 + I7;
        for (int it = gw; it < NITEMS; it += NGW) {
            int r = it;
            if (r < I0) { tr_item(P.in[2], D, NIN0, WIN0, P.in[1], 1, scr, r, lane); continue; } r -= I0;
            if (r < I1) { tr_item(P.in[8], D, D, WOUT0, nullptr, 0, scr, r, lane); continue; } r -= I1;
            if (r < I2) { tr_item(P.in[18], D, FF, W1_0, P.in[17], 0, scr, r, lane); continue; } r -= I2;
            if (r < I3) { tr_item(P.in[19], FF, D, W2_0, nullptr, 0, scr, r, lane); continue; } r -= I3;
            if (r < I4) { tr_item(P.in[10], D, NIN1, WIN1, P.in[9], 0, scr, r, lane); continue; } r -= I4;
            if (r < I5) { tr_item(P.in[16], D, D, WOUT1, nullptr, 0, scr, r, lane); continue; } r -= I5;
            if (r < I6) { tr_item(P.in[18] + (size_t)D * FF, D, FF, W1_1, P.in[17] + D, 0, scr, r, lane); continue; } r -= I6;
            tr_item(P.in[19] + (size_t)FF * D, FF, D, W2_1, nullptr, 0, scr, r, lane);
        }
        { bf16_t* WSB = (bf16_t*)(ws + WS_WSB); const float* wsrc = P.in[14];
          for (int i = vblk * NTHR + tid; i < 8 * 128 * 128 / 2; i += G * NTHR) { const int e = 2 * i, s = e & 127, t = (e >> 7) & 127; const f32x2 v = *(const f32x2*)(wsrc + e);
              ((unsigned*)WSB)[i] = cvt_pk_bf16(s <= t ? v.x : 0.f, (s + 1) <= t ? v.y : 0.f); } }
        const float* x = P.in[0];
        const int RPG = M / NGRP0, rbase = xg0 * RPG, lw = xr0 * NWAVES + wave, LW = XR0 * NWAVES;
        for (int r0 = lw; r0 < RPG; r0 += 4 * LW) {
            f32x4 v[4][4];
#pragma unroll
            for (int u = 0; u < 4; ++u) { const int row = rbase + ((r0 + u * LW < RPG) ? r0 + u * LW : r0); const f32x4* xr = (const f32x4*)(x + (size_t)row * D) + lane;
#pragma unroll
                for (int j = 0; j < 4; ++j) v[u][j] = __builtin_nontemporal_load(xr + 64 * j); }
#pragma unroll
            for (int u = 0; u < 4; ++u) { const int row = rbase + r0 + u * LW; if (r0 + u * LW < RPG) { float s = 0.f;
#pragma unroll
                for (int j = 0; j < 4; ++j) { const f32x4 t = v[u][j]; s += (t.x * t.x + t.y * t.y) + (t.z * t.z + t.w * t.w);
                    u32x2 o; o.x = cvt_pk_bf16(t.x, t.y); o.y = cvt_pk_bf16(t.z, t.w); *(u32x2*)(XB + (size_t)row * D + 4 * lane + 256 * j) = o; }
                s += __shfl_xor(s, 1); s += __shfl_xor(s, 2);
                if ((lane & 3) == 0) SS0[(size_t)row * 16 + (lane >> 2)] = s; } }
        }
    }
    if (P.ws == nullptr) grid.sync();
    xcd_barrier(xbar);
    xcd_classify(xbar);
    const bool fast = misc[3] != 0u; const unsigned nloc = misc[0];
    const int NGRP = 8, xg = fast ? (int)misc[4] : bx % NGRP, xr = fast ? (int)misc[2] : bx / NGRP, XR = G / NGRP;
    const int cg_ = fast ? xr * 8 + xg : bx;
    bf16_t* const G1w = (bf16_t*)(ws + WS_R + (size_t)xg * (20 * MiB)); bf16_t* const Uw = (bf16_t*)(ws + WS_R + (size_t)xg * (24 * MiB));
    bf16_t* const Vw = (bf16_t*)(ws + WS_R + 8 * MiB + (size_t)xg * (24 * MiB)); bf16_t* const MXw = (bf16_t*)(ws + WS_R + 16 * MiB + (size_t)xg * (24 * MiB));
#define SEAM() do { if (fast) xcd_local_barrier(xbar, nloc); else xcd_barrier(xbar); } while (0)
    const LAS float* const rs_tab = (const LAS float*)(lds + pg8::STAGE_BYTES + 256);
    { pg8::Gemm g{XB, WIN0, M, NIN0, D}; pg8::StaticOrder S; S.init(M, NIN0, G, cg_); pg8::EpiInEven E{G1w, SS0, rs_tab};
      pg8::gemm_phase<pg8::EpiInEven, pg8::StaticOrder, true, true>(lds, g, S, E); }
    SEAM();
    conv_phase(P, G1w, MXw, lds, NGRP, xg, xr, XR);
    SEAM();
    { pg8::Gemm g{MXw, WOUT0, M, D, D}; pg8::StaticOrder S; S.init(M, D, G, cg_); pg8::EpiRes E{XB, XB, SS1};
      pg8::gemm_phase<pg8::EpiRes, pg8::StaticOrder, true, true>(lds, g, S, E); }
    SEAM();
    { pg8::Gemm g{XB, W1_0, M, FF, D}; pg8::StaticOrder S; S.init(M, FF, G, cg_); pg8::EpiHid E{(bf16_t*)(ws + WS_HID), SS1, rs_tab};
      pg8::gemm_phase<pg8::EpiHid, pg8::StaticOrder, true, true>(lds, g, S, E); }
    SEAM();
    { pg8::Gemm g{(const bf16_t*)(ws + WS_HID), W2_0, M, D, FF}; pg8::StaticOrder S; S.init(M, D, G, cg_);
      pg8::EpiRes E{XB, XB, SS2};
      pg8::gemm_phase<pg8::EpiRes, pg8::StaticOrder, true, true>(lds, g, S, E); }
    SEAM();
    { pg8::Gemm g{XB, WIN1, M, NIN1, D}; pg8::StaticOrder S; S.init(M, NIN1, G, cg_);
      pg8::EpiInOdd E{Uw, Vw, SS2, P.in[11], (f32x2*)(ws + WS_VST), rs_tab};
      pg8::gemm_phase<pg8::EpiInOdd, pg8::StaticOrder, true, true>(lds, g, S, E); }
    SEAM();
    sgu_phase(P, Uw, Vw, MXw, lds, NGRP, xg, xr, XR);
    SEAM();
    { pg8::Gemm g{MXw, WOUT1, M, D, D}; pg8::StaticOrder S; S.init(M, D, G, cg_);
      pg8::EpiRes E{XB, XB, SS3};
      pg8::gemm_phase<pg8::EpiRes, pg8::StaticOrder, true, true>(lds, g, S, E); }
    SEAM();
    { pg8::Gemm g{XB, W1_1, M, FF, D}; pg8::StaticOrder S; S.init(M, FF, G, cg_); pg8::EpiHid E{(bf16_t*)(ws + WS_HID), SS3, rs_tab};
      pg8::gemm_phase<pg8::EpiHid, pg8::StaticOrder, true, true>(lds, g, S, E); }
    SEAM();
    { pg8::Gemm g{(const bf16_t*)(ws + WS_HID), W2_1, M, D, FF}; pg8::StaticOrder S; S.init(M, D, G, cg_);
      unsigned* const bw = (unsigned*)(ws + WS_BAR);
      pg8::EpiResFinal E{XB, P.out, P.in[20], (unsigned*)(ws + 60 * MiB), bw + XB_PCNT(0), bw + XB_TMO, (LAS float*)(lds + pg8::STAGE_BYTES + 256)};
      pg8::gemm_phase<pg8::EpiResFinal, pg8::StaticOrder, true, true>(lds, g, S, E); }
}

extern "C" void kernel_launch(void* const* d_in, const int* in_sizes, int n_in, void* d_out, int out_size, void* d_ws, size_t ws_size, hipStream_t stream) {
    static int grid_blocks = 0;
    if (grid_blocks == 0) {
        if (n_in != 21 || in_sizes[0] != M * D || out_size != M * D || ws_size < WS_END) { fprintf(stderr, "kernel_launch: unexpected shapes (n_in %d in0 %d out %d ws %zu)\n", n_in, n_in > 0 ? in_sizes[0] : -1, out_size, ws_size); grid_blocks = -1; return; }
        int dev = 0, cus = 0, per_cu = 0;
        (void)hipGetDevice(&dev); (void)hipDeviceGetAttribute(&cus, hipDeviceAttributeMultiprocessorCount, dev);
        if (hipFuncSetAttribute((const void*)fwd_megakernel, hipFuncAttributeMaxDynamicSharedMemorySize, LDS_BYTES) != hipSuccess) { fprintf(stderr, "kernel_launch: hipFuncSetAttribute failed\n"); grid_blocks = -1; return; }
        if (hipOccupancyMaxActiveBlocksPerMultiprocessor(&per_cu, (const void*)fwd_megakernel, NTHR, LDS_BYTES) != hipSuccess || per_cu < 1) { fprintf(stderr, "kernel_launch: occupancy query says %d\n", per_cu); per_cu = 1; }
        (void)hipGetLastError();
        if (cus % 8 != 0 || cus < 128) { fprintf(stderr, "kernel_launch: needs a CU count that is a multiple of 8 and >= 128 (got %d)\n", cus); grid_blocks = -1; return; }
        grid_blocks = cus * 1;
    }
    if (grid_blocks < 0) return;
    if (hipMemsetAsync((char*)d_ws + WS_BAR, 0, XCD_BAR_WORDS * 4, stream) != hipSuccess) { fprintf(stderr, "kernel_launch: memset of the barrier words failed\n"); return; }
    Params p{};
    for (int i = 0; i < 21; ++i) p.in[i] = (const float*)d_in[i];
    p.out = (float*)d_out; p.ws = (unsigned char*)d_ws;
    void* args[] = {&p};
    hipError_t e = hipLaunchCooperativeKernel((const void*)fwd_megakernel, dim3(grid_blocks), dim3(NTHR), args, LDS_BYTES, stream);
    if (e != hipSuccess) fprintf(stderr, "cooperative launch failed: %s (grid %d)\n", hipGetErrorString(e), grid_blocks);
}
```
